# Optimizing an MI355X kernel written in HIP

```python
import jax
import jax.numpy as jnp
from jax import lax
import numpy as np

D_MODEL = 1024
BATCH = 4
SEQ = 4096
DEPTH = 2

N_EVEN = (DEPTH + 1) // 2
N_ODD = DEPTH // 2
D_FF = 2816
RMS_EPS = 1e-6
MIX_WIDTH = D_MODEL
GMLP_WIDTH = MIX_WIDTH // 2
GMLP_GROUPS = 4
GMLP_GROUP_DIM = GMLP_WIDTH // GMLP_GROUPS
GMLP_CHUNK = 128
MOBA_WIDTH = MIX_WIDTH - GMLP_WIDTH
MOBA_HEAD_DIM = 128
MOBA_HEADS = MOBA_WIDTH // MOBA_HEAD_DIM
MOBA_BLOCK = 256
MOBA_TOPK = 3
MOBA_Q_CHUNK = 64
ROPE_THETA = 500000.0
ROT_DIM = MOBA_HEAD_DIM // 4
HYB_IN_WIDTH = 2 * GMLP_WIDTH + 3 * MOBA_WIDTH
CONV_WIDTH = 3
CONV_DIM = D_MODEL
NEG_INF = -1e30

kernel_name = 'hybrid_gmlp_moba_shortconv_macaron'


def rms_norm(x, g):
    xf = x.astype(jnp.float32)
    y = xf * lax.rsqrt(jnp.mean(xf * xf, axis=-1, keepdims=True) + RMS_EPS)
    return (y * g.astype(jnp.float32)).astype(x.dtype)


def swiglu(x, w_gate, w_up, w_down):
    return (jax.nn.silu(x @ w_gate) * (x @ w_up)) @ w_down


def partial_rotary(x, positions):
    half = ROT_DIM // 2
    inv_freq = ROPE_THETA ** (-jnp.arange(half, dtype=jnp.float32) / half)
    ang = positions.astype(jnp.float32)[..., None] * inv_freq
    cos = jnp.cos(ang)[:, :, None, :]
    sin = jnp.sin(ang)[:, :, None, :]
    xf = x.astype(jnp.float32)
    x1, x2, rest = xf[..., :half], xf[..., half:ROT_DIM], xf[..., ROT_DIM:]
    out = jnp.concatenate([x1 * cos - x2 * sin, x2 * cos + x1 * sin, rest], axis=-1)
    return out.astype(x.dtype)


def chunked_gmlp(u, v, v_norm, w_s, b_s):
    bsz, seq, _ = u.shape
    v = rms_norm(v, v_norm)
    v = v.reshape(bsz, seq // GMLP_CHUNK, GMLP_CHUNK, GMLP_GROUPS, GMLP_GROUP_DIM)
    causal = jnp.tril(jnp.ones((GMLP_CHUNK, GMLP_CHUNK), dtype=bool))
    w = jnp.where(causal, w_s, 0)
    mixed = jnp.einsum('gts,bnsgc->bntgc', w, v) + b_s.T[:, :, None]
    return u * mixed.reshape(bsz, seq, GMLP_WIDTH)


def moba_attention(q, k, v):
    bsz, seq, nh, hd = q.shape
    seq_p = -(-seq // MOBA_BLOCK) * MOBA_BLOCK
    pad = ((0, 0), (0, seq_p - seq), (0, 0), (0, 0))
    q, k, v = [jnp.pad(t, pad).transpose(0, 2, 1, 3) for t in (q, k, v)]
    nb = seq_p // MOBA_BLOCK
    k_blk = k.reshape(bsz, nh, nb, MOBA_BLOCK, hd)
    v_blk = v.reshape(bsz, nh, nb, MOBA_BLOCK, hd)
    k_mean = jnp.mean(k_blk.astype(jnp.float32), axis=3)
    n_sel = min(MOBA_TOPK, nb - 1)
    scale = hd ** -0.5
    nq = seq_p // MOBA_Q_CHUNK
    q_chunks = q.reshape(bsz, nh, nq, MOBA_Q_CHUNK, hd).transpose(2, 0, 1, 3, 4)
    gather_blocks = jax.vmap(jax.vmap(lambda blk, ix: blk[ix]))

    def one_chunk(args):
        qc, ci = args
        q0 = ci * MOBA_Q_CHUNK
        qblk = q0 // MOBA_BLOCK
        qpos = q0 + jnp.arange(MOBA_Q_CHUNK)
        qf = qc.astype(jnp.float32)
        k_own = lax.dynamic_index_in_dim(k_blk, qblk, axis=2, keepdims=False).astype(jnp.float32)
        v_own = lax.dynamic_index_in_dim(v_blk, qblk, axis=2, keepdims=False).astype(jnp.float32)
        kpos = qblk * MOBA_BLOCK + jnp.arange(MOBA_BLOCK)
        s_own = jnp.einsum('bhqd,bhkd->bhqk', qf, k_own) * scale
        s_own = jnp.where(kpos[None, :] <= qpos[:, None], s_own, NEG_INF)
        if n_sel > 0:
            gate = jnp.einsum('bhqd,bhnd->bhqn', qf, k_mean)
            gate = jnp.where(jnp.arange(nb) < qblk, gate, NEG_INF)
            _, sel = lax.top_k(gate, n_sel)
            valid = sel < qblk
            k_sel = gather_blocks(k_blk, sel).astype(jnp.float32)
            v_sel = gather_blocks(v_blk, sel).astype(jnp.float32)
            s_sel = jnp.einsum('bhqd,bhqnkd->bhqnk', qf, k_sel) * scale
            s_sel = jnp.where(valid[..., None], s_sel, NEG_INF)
            s_sel = s_sel.reshape(bsz, nh, MOBA_Q_CHUNK, n_sel * MOBA_BLOCK)
            p = jax.nn.softmax(jnp.concatenate([s_sel, s_own], axis=-1), axis=-1)
            p_sel = p[..., :n_sel * MOBA_BLOCK].reshape(bsz, nh, MOBA_Q_CHUNK, n_sel, MOBA_BLOCK)
            p_own = p[..., n_sel * MOBA_BLOCK:]
            out = (jnp.einsum('bhqnk,bhqnkd->bhqd', p_sel, v_sel)
                   + jnp.einsum('bhqk,bhkd->bhqd', p_own, v_own))
        else:
            p_own = jax.nn.softmax(s_own, axis=-1)
            out = jnp.einsum('bhqk,bhkd->bhqd', p_own, v_own)
        return out.astype(qc.dtype)

    out = lax.map(one_chunk, (q_chunks, jnp.arange(nq)))
    out = out.transpose(1, 0, 3, 2, 4).reshape(bsz, seq_p, nh, hd)[:, :seq]
    return out.reshape(bsz, seq, nh * hd)


def hybrid_ab_mixer(h, positions, w_in, v_norm, w_s, b_s, w_out):
    bsz, seq, _ = h.shape
    proj = h @ w_in
    cuts = [GMLP_WIDTH, 2 * GMLP_WIDTH, 2 * GMLP_WIDTH + MOBA_WIDTH, 2 * GMLP_WIDTH + 2 * MOBA_WIDTH]
    u, v_g, q, k, v = jnp.split(proj, cuts, axis=-1)
    a_out = chunked_gmlp(jax.nn.gelu(u), jax.nn.gelu(v_g), v_norm, w_s, b_s)
    heads = (bsz, seq, MOBA_HEADS, MOBA_HEAD_DIM)
    q = partial_rotary(q.reshape(heads), positions)
    k = partial_rotary(k.reshape(heads), positions)
    b_out = moba_attention(q, k, v.reshape(heads))
    return jnp.concatenate([a_out, b_out], axis=-1) @ w_out


def short_conv_mixer(h, w_in, conv_w, w_out):
    proj = h @ w_in
    b_gate, c_gate, xin = jnp.split(proj, 3, axis=-1)
    z = c_gate * xin
    y = lax.conv_general_dilated(z, conv_w[:, None, :], window_strides=(1,),
                                 padding=[(CONV_WIDTH - 1, 0)],
                                 dimension_numbers=('NWC', 'WIO', 'NWC'),
                                 feature_group_count=CONV_DIM)
    return (b_gate * y) @ w_out


def setup_inputs(seed: int = 0) -> dict:
    key = jax.random.key(seed)
    ks = jax.random.split(key, 16)

    def nrm(k, shape, fan_in):
        return jax.random.normal(k, shape, jnp.float32) * (fan_in ** -0.5)

    def gain(k, shape):
        return 1.0 + 0.02 * jax.random.normal(k, shape, jnp.float32)

    return {
        'x': jax.random.normal(ks[0], (BATCH, SEQ, D_MODEL), jnp.float32),
        'positions': jnp.broadcast_to(jnp.arange(SEQ, dtype=jnp.int32)[None, :], (BATCH, SEQ)),
        'ffn_norm': gain(ks[1], (DEPTH, 2, D_MODEL)),
        'ffn_w_gate': nrm(ks[2], (DEPTH, 2, D_MODEL, D_FF), D_MODEL),
        'ffn_w_up': nrm(ks[3], (DEPTH, 2, D_MODEL, D_FF), D_MODEL),
        'ffn_w_down': nrm(ks[4], (DEPTH, 2, D_FF, D_MODEL), D_FF),
        'mix_norm': gain(ks[5], (DEPTH, D_MODEL)),
        'hyb_w_in': nrm(ks[6], (N_EVEN, D_MODEL, HYB_IN_WIDTH), D_MODEL),
        'gmlp_v_norm': gain(ks[7], (N_EVEN, GMLP_WIDTH)),
        'gmlp_w_s': nrm(ks[8], (N_EVEN, GMLP_GROUPS, GMLP_CHUNK, GMLP_CHUNK), GMLP_CHUNK),
        'gmlp_b_s': 1.0 + 0.1 * jax.random.normal(ks[9], (N_EVEN, GMLP_GROUPS, GMLP_CHUNK), jnp.float32),
        'hyb_w_out': nrm(ks[10], (N_EVEN, MIX_WIDTH, D_MODEL), MIX_WIDTH),
        'conv_w_in': nrm(ks[11], (N_ODD, D_MODEL, 3 * CONV_DIM), D_MODEL),
        'conv_w': nrm(ks[12], (N_ODD, CONV_WIDTH, CONV_DIM), CONV_WIDTH),
        'conv_w_out': nrm(ks[13], (N_ODD, CONV_DIM, D_MODEL), CONV_DIM),
        'final_norm': gain(ks[14], (D_MODEL,)),
    }


def reference(x, positions, ffn_norm, ffn_w_gate, ffn_w_up, ffn_w_down, mix_norm,
              hyb_w_in, gmlp_v_norm, gmlp_w_s, gmlp_b_s, hyb_w_out,
              conv_w_in, conv_w, conv_w_out, final_norm):
    for layer in range(DEPTH):
        x = x + 0.5 * swiglu(rms_norm(x, ffn_norm[layer, 0]), ffn_w_gate[layer, 0],
                             ffn_w_up[layer, 0], ffn_w_down[layer, 0])
        h = rms_norm(x, mix_norm[layer])
        i = layer // 2
        if layer % 2 == 0:
            x = x + hybrid_ab_mixer(h, positions, hyb_w_in[i], gmlp_v_norm[i], gmlp_w_s[i],
                                    gmlp_b_s[i], hyb_w_out[i])
        else:
            x = x + short_conv_mixer(h, conv_w_in[i], conv_w[i], conv_w_out[i])
        x = x + 0.5 * swiglu(rms_norm(x, ffn_norm[layer, 1]), ffn_w_gate[layer, 1],
                             ffn_w_up[layer, 1], ffn_w_down[layer, 1])
    return rms_norm(x, final_norm)
```

```cpp
#include <hip/hip_runtime.h>
#include <hip/hip_cooperative_groups.h>
#include <cstdio>
#include <cstdint>
#include <cmath>
namespace cg = cooperative_groups;

namespace pg8 {
#define PG8_LAS __attribute__((address_space(3)))
typedef unsigned short bf16_t;
typedef short bf16x8 __attribute__((ext_vector_type(8)));
typedef float f32x4 __attribute__((ext_vector_type(4)));
typedef unsigned u32x4 __attribute__((ext_vector_type(4)));
constexpr int BM = 256, BK = 64, HALF = 128, HTB = HALF * BK * 2  , STAGE_BYTES = 8 * HTB, NXCD = 8, WGM = 8;

__host__ __device__ __forceinline__ int lds_byte(int r, int c) { const int st = (r >> 4) * 2 + (c >> 5), rr = r & 15, cc = c & 31, ob = rr * 64 + cc * 2; return st * 1024 + (ob ^ (((ob >> 9) & 1) << 5)); }
__host__ __device__ __forceinline__ void stage_rc(int b, int& R, int& C) { const int st = b / 1024, sb = b % 1024, swz = sb ^ (((sb >> 9) & 1) << 5); R = (st >> 1) * 16 + swz / 64; C = (st & 1) * 32 + (swz % 64) / 2; }
__host__ __device__ __forceinline__ int perm32(int rho) { const int n = rho >> 4, i = rho & 15; return 8 * (i >> 2) + 4 * n + (i & 3); }

struct Unit { int pm, pn; };
struct Gemm { const bf16_t* A; const bf16_t* Bt; int M, N, K; };

struct StaticOrder {
    int nM, nN, nwg, G, c;
    __host__ __device__ void init(int M, int N, int G_, int c_) { nM = M / BM; nN = N / BM; nwg = nM * nN; G = G_; c = c_; }
    __host__ __device__ bool next(int i, Unit& u) const {
        const long L = (long)i * G + c; if (L >= nwg) return false;
        int wgid = (int)L; { const int q = nwg / NXCD, r = nwg % NXCD, xcd = wgid % NXCD, off = wgid / NXCD; wgid = (xcd < r ? xcd * (q + 1) : r * (q + 1) + (xcd - r) * q) + off; }
        const int nig = WGM * nN, gid = wgid / nig, fm = gid * WGM, gsz = (nM - fm) < WGM ? (nM - fm) : WGM;
        u.pm = fm + ((wgid % nig) % gsz); u.pn = (wgid % nig) / gsz; return true;
    }
    __device__ __forceinline__ void a_ready(const Unit&) const {}
    __device__ __forceinline__ void done(const Unit&) const {}
};
__device__ __forceinline__ unsigned cvt_pk_bf16(float lo, float hi) { unsigned r; asm volatile("v_cvt_pk_bf16_f32 %0, %1, %2" : "=v"(r) : "v"(lo), "v"(hi)); return r; }
typedef unsigned u32x2 __attribute__((ext_vector_type(2)));
constexpr float RMS_EPS_ = 1e-6f;
__device__ __forceinline__ float ssq_sum16(const float* ssq, int row) { const f32x4* p = (const f32x4*)(ssq + (size_t)row * 16); const f32x4 a = (p[0] + p[1]) + (p[2] + p[3]); return (a[0] + a[1]) + (a[2] + a[3]); }
__device__ __forceinline__ float rstd_row(const float* ssq, int row, float invn) { return __builtin_amdgcn_rsqf(ssq_sum16(ssq, row) * invn + RMS_EPS_); }
__device__ __forceinline__ float sigmoid_fast(float x) { return __builtin_amdgcn_rcpf(1.0f + __builtin_amdgcn_exp2f(-1.4426950408889634f * x)); }
__device__ __forceinline__ float gelu_tanh(float x) { const float y = 0.7978845608028654f * (x + 0.044715f * x * x * x); return x * sigmoid_fast(2.0f * y); }

__device__ __forceinline__ void rstd8(const float* ssq, int row0, int fq, float invn, float (&rs)[2][4]) {
    f32x4 part[2][4];
#pragma unroll
    for (int ai = 0; ai < 2; ++ai)
#pragma unroll
        for (int m = 0; m < 4; ++m) part[ai][m] = *(const f32x4*)(ssq + (size_t)(row0 + ai * HALF + m * 16) * 16 + 4 * fq);
#pragma unroll
    for (int ai = 0; ai < 2; ++ai)
#pragma unroll
        for (int m = 0; m < 4; ++m) { float t = (part[ai][m][0] + part[ai][m][1]) + (part[ai][m][2] + part[ai][m][3]); t += __shfl_xor(t, 16); t += __shfl_xor(t, 32);
            rs[ai][m] = __builtin_amdgcn_rsqf(t * invn + RMS_EPS_); }
}
struct EpiSwiGLU {
    static constexpr bool PERM = true, AFTER_DRAIN = false;
    bf16_t* O; const float* ssq;
    __device__ __forceinline__ void operator()(const f32x4 (&acc)[2][2][4][2], const Unit& u, int wr, int wc, int fr, int fq) const {
        const int row0 = u.pm * BM + wr * 64 + fr, col0 = u.pn * 128 + wc * 32 + 8 * fq;
        float rsv[2][4]; rstd8(ssq, row0, fq, 1.0f / 1024.0f, rsv);
#pragma unroll
        for (int ai = 0; ai < 2; ++ai)
#pragma unroll
            for (int m = 0; m < 4; ++m) { const int row = row0 + ai * HALF + m * 16; const float rs = rsv[ai][m];
                float h[8];
#pragma unroll
                for (int n = 0; n < 2; ++n)
#pragma unroll
                    for (int i = 0; i < 4; ++i) { const float g = acc[ai][0][m][n][i] * rs, up = acc[ai][1][m][n][i] * rs; h[4 * n + i] = g * sigmoid_fast(g) * up; }
                u32x4 w; w.x = cvt_pk_bf16(h[0], h[1]); w.y = cvt_pk_bf16(h[2], h[3]); w.z = cvt_pk_bf16(h[4], h[5]); w.w = cvt_pk_bf16(h[6], h[7]);
                *(u32x4*)(O + (size_t)row * 2816 + col0) = w; }
    }
};
struct EpiResid {
    static constexpr bool PERM = false, AFTER_DRAIN = false;
    bf16_t* XB; float* ssq_out; float scale;
    __device__ __forceinline__ void operator()(const f32x4 (&acc)[2][2][4][2], const Unit& u, int wr, int wc, int fr, int fq) const {
        const int row0 = u.pm * BM + wr * 64 + fr, col0 = u.pn * BM + wc * 32 + 4 * fq;
#pragma unroll
        for (int ai = 0; ai < 2; ++ai) {
            u32x2 b[4][2][2];
#pragma unroll
            for (int m = 0; m < 4; ++m)
#pragma unroll
                for (int bj = 0; bj < 2; ++bj)
#pragma unroll
                    for (int n = 0; n < 2; ++n) b[m][bj][n] = *(const u32x2*)(XB + (size_t)(row0 + ai * HALF + m * 16) * 1024 + col0 + bj * HALF + n * 16);
#pragma unroll
            for (int m = 0; m < 4; ++m) { const int row = row0 + ai * HALF + m * 16; float ss = 0.f;
#pragma unroll
                for (int bj = 0; bj < 2; ++bj)
#pragma unroll
                    for (int n = 0; n < 2; ++n) { const size_t off = (size_t)row * 1024 + col0 + bj * HALF + n * 16; const u32x2 bb = b[m][bj][n];
                        f32x4 v; v[0] = __builtin_bit_cast(float, bb.x << 16); v[1] = __builtin_bit_cast(float, bb.x & 0xffff0000u); v[2] = __builtin_bit_cast(float, bb.y << 16); v[3] = __builtin_bit_cast(float, bb.y & 0xffff0000u);
                        v = v + acc[ai][bj][m][n] * scale;
                        u32x2 w; w.x = cvt_pk_bf16(v[0], v[1]); w.y = cvt_pk_bf16(v[2], v[3]); *(u32x2*)(XB + off) = w;
                        ss += (v[0] * v[0] + v[1] * v[1]) + (v[2] * v[2] + v[3] * v[3]); }
                ss += __shfl_xor(ss, 16); ss += __shfl_xor(ss, 32);
                if (fq == 0) ssq_out[(size_t)row * 16 + u.pn * 4 + wc] = ss; }
            asm volatile("" ::: "memory"); }
    }
};
struct EpiHybIn {
    static constexpr bool PERM = false, AFTER_DRAIN = false;
    bf16_t *U, *VG, *Q, *K, *V; const float* ssq; float* ssqv; float* ksum; const float* rope;
    __device__ __forceinline__ void operator()(const f32x4 (&acc)[2][2][4][2], const Unit& u, int wr, int wc, int fr, int fq) const {
        const int row0 = u.pm * BM + wr * 64 + fr, type = u.pn >> 1, cb = (u.pn & 1) * 256 + wc * 32 + 4 * fq;
        bf16_t* dst = type == 0 ? U : type == 1 ? VG : type == 2 ? Q : type == 3 ? K : V;
        float rsv[2][4]; rstd8(ssq, row0, fq, 1.0f / 1024.0f, rsv);
        f32x4 ks[2][2];
#pragma unroll
        for (int bj = 0; bj < 2; ++bj)
#pragma unroll
            for (int n = 0; n < 2; ++n) ks[bj][n] = (f32x4){0.f, 0.f, 0.f, 0.f};
#pragma unroll
        for (int ai = 0; ai < 2; ++ai)
#pragma unroll
            for (int m = 0; m < 4; ++m) { const int row = row0 + ai * HALF + m * 16; const float rs = rsv[ai][m];
                f32x4 v[2][2];
#pragma unroll
                for (int bj = 0; bj < 2; ++bj)
#pragma unroll
                    for (int n = 0; n < 2; ++n) v[bj][n] = acc[ai][bj][m][n] * rs;
                if (type <= 1) { float ss = 0.f;
#pragma unroll
                    for (int bj = 0; bj < 2; ++bj)
#pragma unroll
                        for (int n = 0; n < 2; ++n)
#pragma unroll
                            for (int i = 0; i < 4; ++i) { const float g = gelu_tanh(v[bj][n][i]); v[bj][n][i] = g; ss += g * g; }
                    if (type == 1) { ss += __shfl_xor(ss, 16); ss += __shfl_xor(ss, 32); if (fq == 0) ssqv[(size_t)row * 8 + (u.pn & 1) * 4 + wc] = ss; } }
                if ((type == 2 || type == 3) && wc == 0) {
                    const f32x4 c4 = *(const f32x4*)(rope + (size_t)row * 32 + 4 * fq), s4 = *(const f32x4*)(rope + (size_t)row * 32 + 16 + 4 * fq);
#pragma unroll
                    for (int bj = 0; bj < 2; ++bj) { const f32x4 x1 = v[bj][0], x2 = v[bj][1]; v[bj][0] = x1 * c4 - x2 * s4; v[bj][1] = x2 * c4 + x1 * s4; } }
                if (type == 3) {
#pragma unroll
                    for (int bj = 0; bj < 2; ++bj)
#pragma unroll
                        for (int n = 0; n < 2; ++n) ks[bj][n] += v[bj][n]; }
#pragma unroll
                for (int bj = 0; bj < 2; ++bj)
#pragma unroll
                    for (int n = 0; n < 2; ++n) { u32x2 w; w.x = cvt_pk_bf16(v[bj][n][0], v[bj][n][1]); w.y = cvt_pk_bf16(v[bj][n][2], v[bj][n][3]);
                        if (type <= 1) *(u32x2*)(dst + (size_t)row * 512 + cb + bj * HALF + n * 16) = w;
                        else *(u32x2*)(dst + ((size_t)((row >> 12) * 4 + (u.pn & 1) * 2 + bj) * 4096 + (row & 4095)) * 128 + wc * 32 + 4 * fq + n * 16) = w;   } }
        if (type == 3) {
#pragma unroll
            for (int bj = 0; bj < 2; ++bj)
#pragma unroll
                for (int n = 0; n < 2; ++n)
#pragma unroll
                    for (int i = 0; i < 4; ++i) { float s = ks[bj][n][i]; s += __shfl_xor(s, 1); s += __shfl_xor(s, 2); s += __shfl_xor(s, 4); s += __shfl_xor(s, 8);
                        if (fr == 0) ksum[(size_t)(u.pm * 2 + wr) * 512 + cb + bj * HALF + n * 16 + i] = s; } }
    }
};
struct EpiConvIn {
    static constexpr bool PERM = true, AFTER_DRAIN = false;
    bf16_t *BG, *Z; const float* ssq;
    __device__ __forceinline__ void operator()(const f32x4 (&acc)[2][2][4][2], const Unit& u, int wr, int wc, int fr, int fq) const {
        const int row0 = u.pm * BM + wr * 64 + fr;
        float rsv[2][4]; rstd8(ssq, row0, fq, 1.0f / 1024.0f, rsv);
#pragma unroll
        for (int ai = 0; ai < 2; ++ai)
#pragma unroll
            for (int m = 0; m < 4; ++m) { const int row = row0 + ai * HALF + m * 16; const float rs = rsv[ai][m];
                if (u.pn < 4) {
#pragma unroll
                    for (int bj = 0; bj < 2; ++bj) { const f32x4 a = acc[ai][bj][m][0] * rs, b = acc[ai][bj][m][1] * rs;
                        u32x4 w; w.x = cvt_pk_bf16(a[0], a[1]); w.y = cvt_pk_bf16(a[2], a[3]); w.z = cvt_pk_bf16(b[0], b[1]); w.w = cvt_pk_bf16(b[2], b[3]);
                        *(u32x4*)(BG + (size_t)row * 1024 + u.pn * 256 + bj * HALF + wc * 32 + 8 * fq) = w; }
                } else { const float r2 = rs * rs; const f32x4 a = acc[ai][0][m][0] * acc[ai][1][m][0] * r2, b = acc[ai][0][m][1] * acc[ai][1][m][1] * r2;
                    u32x4 w; w.x = cvt_pk_bf16(a[0], a[1]); w.y = cvt_pk_bf16(a[2], a[3]); w.z = cvt_pk_bf16(b[0], b[1]); w.w = cvt_pk_bf16(b[2], b[3]);
                    *(u32x4*)(Z + (size_t)row * 1024 + (u.pn - 4) * 128 + wc * 32 + 8 * fq) = w; } }
    }
};
template <class Epi, class Sched, bool ALIGN_EPI = false, bool SP2 = false>
__device__ __forceinline__ void gemm_phase(PG8_LAS unsigned char* lds, const Gemm g, const Sched& S, const Epi& E, const int wave_s) {
    unsigned ones_o = ~0u; asm volatile("" : "+s"(ones_o)); const int tid_o = (int)__builtin_amdgcn_mbcnt_hi(ones_o, __builtin_amdgcn_mbcnt_lo(ones_o, 0u)) | (wave_s << 6);
    const int tid = tid_o, wid = __builtin_amdgcn_readfirstlane(tid >> 6), lane = tid & 63, wr = wid >> 2, wc = wid & 3, fr = lane & 15, fq = lane >> 4;
    const int K = g.K, nt = K / BK;
    unsigned voffA[2], voffB[2];
#pragma unroll
    for (int i = 0; i < 2; ++i) { int R, C; stage_rc(tid * 16 + i * 8192, R, C); const int Rb = Epi::PERM ? ((R & ~31) + perm32(R & 31)) : R;
        voffA[i] = (unsigned)(R * K + C) * 2u; voffB[i] = (unsigned)(Rb * K + C) * 2u; }
    const size_t kstep = (size_t)(BK * 2);
    const size_t hstep = (size_t)HALF * K * 2;
    const size_t tstep = 2 * hstep;
    const unsigned ldsw = (unsigned)wid * 1024u;
    const int aoff = lds_byte(wr * 64 + fr, fq * 8), boff = lds_byte(wc * 32 + fr, fq * 8);
#define PG8_SA(b, h) (((b) * 2 + (h)) * HTB)
#define PG8_SB(b, h) ((4 + (b) * 2 + (h)) * HTB)
#define PG8_STAGE(bufoff, gbase, voff) do { _Pragma("unroll") for (int _i = 0; _i < 2; ++_i) \
        __builtin_amdgcn_global_load_lds((const unsigned*)((const char*)(gbase) + (voff)[_i]), (PG8_LAS unsigned*)(lds + (bufoff) + ldsw + _i * 8192), 16, 0, 0); } while (0)
#define PG8_LDA(dst, b, h) do { _Pragma("unroll") for (int m = 0; m < 4; ++m) _Pragma("unroll") for (int k = 0; k < 2; ++k) dst[m][k] = *(const PG8_LAS bf16x8*)(lds + PG8_SA(b, h) + aoff + m * 2048 + k * 1024); } while (0)
#define PG8_LDB(dst, b, h) do { _Pragma("unroll") for (int n = 0; n < 2; ++n) _Pragma("unroll") for (int k = 0; k < 2; ++k) dst[n][k] = *(const PG8_LAS bf16x8*)(lds + PG8_SB(b, h) + boff + n * 2048 + k * 1024); } while (0)
#define PG8_MMA(ai, bj, At, Bt) do { __builtin_amdgcn_s_setprio(1); _Pragma("unroll") for (int m = 0; m < 4; ++m) _Pragma("unroll") for (int n = 0; n < 2; ++n) _Pragma("unroll") for (int k = 0; k < 2; ++k) \
        acc[ai][bj][m][n] = __builtin_amdgcn_mfma_f32_16x16x32_bf16(Bt[n][k], At[m][k], acc[ai][bj][m][n], 0, 0, 0); __builtin_amdgcn_s_setprio(0); } while (0)
#define PG8_WAIT_V(n) asm volatile("s_waitcnt vmcnt(" #n ")" ::: "memory")
#define PG8_WAIT_L(n) asm volatile("s_waitcnt lgkmcnt(" #n ")" ::: "memory")
#define PG8_BAR __builtin_amdgcn_s_barrier()
#define PG8_SCHED __builtin_amdgcn_sched_barrier(0)
    Unit cur, nxt; int ui = 0;
    if (!S.next(0, cur)) return;
    f32x4 acc[2][2][4][2];
#pragma unroll
    for (int a = 0; a < 2; ++a)
#pragma unroll
        for (int b = 0; b < 2; ++b)
#pragma unroll
            for (int m = 0; m < 4; ++m)
#pragma unroll
                for (int n = 0; n < 2; ++n) acc[a][b][m][n] = (f32x4){0.f, 0.f, 0.f, 0.f};
    bf16x8 At[4][2], B0[2][2], B1[2][2];
    const char* cA = (const char*)g.A + (size_t)cur.pm * tstep; const char* cB = (const char*)g.Bt + (size_t)cur.pn * tstep;
    S.a_ready(cur);
    if constexpr (SP2) {
        PG8_STAGE(PG8_SB(0, 0), cB, voffB); PG8_STAGE(PG8_SB(0, 1), cB + hstep, voffB); PG8_STAGE(PG8_SA(0, 0), cA, voffA); PG8_STAGE(PG8_SA(0, 1), cA + hstep, voffA);
        if (wr == 1) PG8_BAR;
        PG8_WAIT_V(2); PG8_BAR;
        PG8_STAGE(PG8_SB(1, 0), cB + kstep, voffB); PG8_STAGE(PG8_SA(1, 0), cA + kstep, voffA); PG8_STAGE(PG8_SB(1, 1), cB + hstep + kstep, voffB);
        PG8_WAIT_V(6); PG8_BAR;
    } else {
        PG8_STAGE(PG8_SB(0, 0), cB, voffB); PG8_STAGE(PG8_SA(0, 0), cA, voffA); PG8_STAGE(PG8_SB(0, 1), cB + hstep, voffB); PG8_STAGE(PG8_SA(0, 1), cA + hstep, voffA);
        if (wr == 1) PG8_BAR;
        PG8_WAIT_V(4); PG8_BAR;
        PG8_STAGE(PG8_SB(1, 0), cB + kstep, voffB); PG8_STAGE(PG8_SA(1, 0), cA + kstep, voffA); PG8_STAGE(PG8_SB(1, 1), cB + hstep + kstep, voffB);
        PG8_WAIT_V(6); PG8_BAR;
    }
    for (;;) {
        const bool has_next = S.next(ui + 1, nxt);
        const char* nA = has_next ? (const char*)g.A + (size_t)nxt.pm * tstep : cA; const char* nB = has_next ? (const char*)g.Bt + (size_t)nxt.pn * tstep : cB;
        for (int t = 0; t < nt; t += 2) {
            const bool last = (t == nt - 2);
            const char* a1 = cA + (size_t)(t + 1) * kstep;
            const char* a2 = last ? nA : cA + (size_t)(t + 2) * kstep; const char* b2 = last ? nB : cB + (size_t)(t + 2) * kstep;
            const char* a3 = a2 + kstep; const char* b3 = b2 + kstep;
            if (last && has_next) S.a_ready(nxt);
            if constexpr (SP2) {
            PG8_LDB(B0, 0, 0); PG8_LDB(B1, 0, 1); PG8_SCHED; PG8_LDA(At, 0, 0); PG8_STAGE(PG8_SA(1, 1), a1 + hstep, voffA);
            PG8_WAIT_V(8); PG8_WAIT_L(0); PG8_BAR; PG8_MMA(0, 0, At, B0); PG8_MMA(0, 1, At, B1); PG8_BAR; PG8_SCHED;
            PG8_LDA(At, 0, 1); PG8_STAGE(PG8_SB(0, 0), b2, voffB); PG8_STAGE(PG8_SB(0, 1), b2 + hstep, voffB); PG8_STAGE(PG8_SA(0, 0), a2, voffA);
            PG8_WAIT_V(8); PG8_WAIT_L(0); PG8_BAR; PG8_MMA(1, 0, At, B0); PG8_MMA(1, 1, At, B1); PG8_BAR; PG8_SCHED;
            PG8_LDB(B0, 1, 0); PG8_LDB(B1, 1, 1); PG8_SCHED; PG8_LDA(At, 1, 0); PG8_STAGE(PG8_SA(0, 1), a2 + hstep, voffA);
            PG8_WAIT_V(8); PG8_WAIT_L(0); PG8_BAR; PG8_MMA(0, 0, At, B0); PG8_MMA(0, 1, At, B1); PG8_BAR; PG8_SCHED;
            PG8_LDA(At, 1, 1); PG8_STAGE(PG8_SB(1, 0), b3, voffB); PG8_STAGE(PG8_SB(1, 1), b3 + hstep, voffB); PG8_STAGE(PG8_SA(1, 0), a3, voffA);
            PG8_WAIT_V(8); PG8_WAIT_L(0); PG8_BAR; PG8_MMA(1, 0, At, B0); PG8_MMA(1, 1, At, B1); PG8_BAR; PG8_SCHED;
            } else {
            PG8_LDB(B0, 0, 0); PG8_SCHED; PG8_LDA(At, 0, 0); PG8_STAGE(PG8_SA(1, 1), a1 + hstep, voffA);
            PG8_WAIT_L(8); PG8_BAR; PG8_WAIT_L(0); PG8_MMA(0, 0, At, B0); PG8_BAR; PG8_SCHED;
            PG8_LDB(B1, 0, 1); PG8_STAGE(PG8_SB(0, 0), b2, voffB);
            PG8_BAR; PG8_WAIT_L(0); PG8_MMA(0, 1, At, B1); PG8_BAR;
            PG8_LDA(At, 0, 1); PG8_STAGE(PG8_SA(0, 0), a2, voffA);
            PG8_BAR; PG8_WAIT_L(0); PG8_MMA(1, 0, At, B0); PG8_BAR; PG8_SCHED;
            PG8_STAGE(PG8_SB(0, 1), b2 + hstep, voffB);
            PG8_WAIT_V(6); PG8_BAR; PG8_MMA(1, 1, At, B1); PG8_BAR;
            PG8_LDB(B0, 1, 0); PG8_SCHED; PG8_LDA(At, 1, 0); PG8_STAGE(PG8_SA(0, 1), a2 + hstep, voffA);
            PG8_WAIT_L(8); PG8_BAR; PG8_WAIT_L(0); PG8_MMA(0, 0, At, B0); PG8_BAR; PG8_SCHED;
            PG8_LDB(B1, 1, 1); PG8_STAGE(PG8_SB(1, 0), b3, voffB);
            PG8_BAR; PG8_WAIT_L(0); PG8_MMA(0, 1, At, B1); PG8_BAR;
            PG8_LDA(At, 1, 1); PG8_STAGE(PG8_SA(1, 0), a3, voffA);
            PG8_BAR; PG8_WAIT_L(0); PG8_MMA(1, 0, At, B0); PG8_BAR; PG8_SCHED;
            PG8_STAGE(PG8_SB(1, 1), b3 + hstep, voffB);
            PG8_WAIT_V(6); PG8_BAR; PG8_MMA(1, 1, At, B1); PG8_BAR;
            }
        }
        if constexpr (ALIGN_EPI) { if (wr == 0) PG8_BAR; }
        if constexpr (!Epi::AFTER_DRAIN) { E(acc, cur, wr, wc, fr, fq); S.done(cur); }
        if (!has_next) break;
#pragma unroll
        for (int a = 0; a < 2; ++a)
#pragma unroll
            for (int b = 0; b < 2; ++b)
#pragma unroll
                for (int m = 0; m < 4; ++m)
#pragma unroll
                    for (int n = 0; n < 2; ++n) acc[a][b][m][n] = (f32x4){0.f, 0.f, 0.f, 0.f};
        cur = nxt; cA = nA; cB = nB; ++ui;
        if constexpr (ALIGN_EPI) { if (wr == 1) PG8_BAR; }
    }
    PG8_WAIT_V(0);
    if constexpr (!ALIGN_EPI) { if (wr == 0) PG8_BAR; }
    PG8_BAR;
    if constexpr (Epi::AFTER_DRAIN) { E.fused(acc, cur, wr, wc, fr, fq, lds, wid, lane); S.done(cur); }
#undef PG8_SA
#undef PG8_SB
#undef PG8_STAGE
#undef PG8_LDA
#undef PG8_LDB
#undef PG8_MMA
#undef PG8_WAIT_V
#undef PG8_WAIT_L
#undef PG8_BAR
#undef PG8_SCHED
}
}
#define LAS __attribute__((address_space(3)))
typedef unsigned short bf16;
typedef float f32x4 __attribute__((ext_vector_type(4)));
typedef float f32x16 __attribute__((ext_vector_type(16)));
typedef short bf16x8 __attribute__((ext_vector_type(8)));
typedef short s16x4 __attribute__((ext_vector_type(4)));
typedef unsigned u32x4 __attribute__((ext_vector_type(4)));
typedef unsigned u32x2 __attribute__((ext_vector_type(2)));
typedef short v4i16_t __attribute__((ext_vector_type(4)));

constexpr int M_ = 16384, D_ = 1024, FF_ = 2816, SEQ_ = 4096, NWAVES = 8, NTHR = 512;
constexpr int LDS_BYTES = 147456;
constexpr size_t MiB = 1u << 20;
constexpr size_t WS_SSQ = 232 * MiB;
constexpr size_t WS_SSQV = 240 * MiB;
constexpr size_t WS_KSUM = 241 * MiB;
constexpr size_t WS_ROPE = 1 * MiB;
constexpr size_t WS_BAR = 3 * MiB, BAR_BYTES = 16384;
constexpr int LDS_CTL_OFF = 131072;
constexpr size_t WS_WFFN = 4 * MiB, WFFN_STRIDE = 17 * MiB, WFFN_DN = 11 * MiB;
constexpr size_t WS_HYBIN = 72 * MiB, WS_HYBOUT = 77 * MiB, WS_CONVIN = 79 * MiB, WS_CONVOUT = 85 * MiB;
constexpr size_t WS_XB = 88 * MiB, WS_ACT = 120 * MiB;
constexpr size_t WS_U = 120 * MiB, WS_VG = 136 * MiB, WS_Q = 152 * MiB, WS_K = 168 * MiB, WS_V = 184 * MiB, WS_AB = 200 * MiB;
constexpr size_t WS_BG = 120 * MiB, WS_Z = 152 * MiB, WS_CM = 184 * MiB;
constexpr size_t WS_END = 242 * MiB;

__device__ __forceinline__ unsigned f2bf(float f) { unsigned u = __builtin_bit_cast(unsigned, f); return (u + 0x7fffu + ((u >> 16) & 1u)) >> 16; }
typedef __bf16 hw_bf16x2 __attribute__((ext_vector_type(2)));
typedef float hw_f32x2 __attribute__((ext_vector_type(2)));
__device__ __forceinline__ unsigned pk2(float lo, float hi) { const hw_f32x2 v = {lo, hi}; const hw_bf16x2 b = __builtin_convertvector(v, hw_bf16x2); return __builtin_bit_cast(unsigned, b); }
__device__ __forceinline__ float bf_lo(unsigned w) { return __builtin_bit_cast(float, w << 16); }
__device__ __forceinline__ float bf_hi(unsigned w) { return __builtin_bit_cast(float, w & 0xffff0000u); }
__device__ __forceinline__ float wave_sum(float v) {
#pragma unroll
    for (int o = 1; o < 64; o <<= 1) v += __shfl_xor(v, o);
    return v;
}
#define LDS_WAIT() asm volatile("s_waitcnt lgkmcnt(0)" ::: "memory")

__device__ __forceinline__ void transpose_item(const float* W, int ldw, int K, int c0, bf16* WT, int n_dst0, const float* gain, int kb, int lane) {
    const int n4 = lane & 7, kq = lane >> 3, k0 = 64 * kb + 8 * kq;
    const float* src = W + (size_t)k0 * ldw + c0 + 4 * n4;
    f32x4 v[8];
#pragma unroll
    for (int i = 0; i < 8; ++i) v[i] = __builtin_nontemporal_load((const f32x4*)(src + (size_t)i * ldw));
    __builtin_amdgcn_sched_barrier(0);
    if (gain) { const f32x4 g0 = *(const f32x4*)(gain + k0), g1 = *(const f32x4*)(gain + k0 + 4);
#pragma unroll
        for (int i = 0; i < 4; ++i) { v[i] = v[i] * g0[i]; v[4 + i] = v[4 + i] * g1[i]; } }
#pragma unroll
    for (int jn = 0; jn < 4; ++jn) { u32x4 o; o.x = pk2(v[0][jn], v[1][jn]); o.y = pk2(v[2][jn], v[3][jn]); o.z = pk2(v[4][jn], v[5][jn]); o.w = pk2(v[6][jn], v[7][jn]);
        *(u32x4*)(WT + (size_t)(n_dst0 + 4 * n4 + jn) * K + k0) = o; }
}

#define XB_TMO      128
#define XB_XCNT(j)  (256  + 64 * (j))
#define XB_XSUB(j)  (1280 + 64 * (j))
#define XB_XGEN(j)  (2304 + 64 * (j))
#define XB_TOP      3328
#define XB_TOPGEN   3392
#define XCD_BAR_WORDS 3456
#define XB_SPIN_CAP (1u << 18)

__device__ __forceinline__ unsigned xb_ld(unsigned* p)              { return __hip_atomic_load(p, __ATOMIC_RELAXED, __HIP_MEMORY_SCOPE_AGENT); }
__device__ __forceinline__ unsigned xb_add(unsigned* p, unsigned v) { return __hip_atomic_fetch_add(p, v, __ATOMIC_RELAXED, __HIP_MEMORY_SCOPE_AGENT); }
__device__ __forceinline__ unsigned xb_xcc_id() { return (unsigned)__builtin_amdgcn_s_getreg((3 << 11) | 20) & 0xFu; }
#define XB_SPIN(cond, bar) do { unsigned _sp = 0; while (cond) { __builtin_amdgcn_s_sleep(1); \
    if ((++_sp & 255u) == 0u) { if (xb_ld(&(bar)[XB_TMO])) break; if (_sp > XB_SPIN_CAP) { atomicAdd(&(bar)[XB_TMO], 1u); break; } } } } while (0)

struct XcdBarrier {
    unsigned* bar; unsigned x;
    volatile LAS unsigned* st;
};

__device__ __forceinline__ XcdBarrier xcd_barrier_post(unsigned* bar, volatile LAS unsigned* st) {
    XcdBarrier b; b.bar = bar; b.x = xb_xcc_id(); b.st = st;
    if (threadIdx.x == 0) (void)xb_add(&bar[XB_XCNT(b.x)], 1u);
    return b;
}
__device__ __forceinline__ void xcd_barrier_complete(unsigned* bar, unsigned x, unsigned& nloc, unsigned& nx) {
    const unsigned G = gridDim.x * gridDim.y * gridDim.z;
    unsigned sum, cnt, mine, sp = 0u;
    for (;;) {
        sum = 0u; cnt = 0u; mine = 0u;
#pragma unroll
        for (unsigned j = 0; j < 16; ++j) { const unsigned c = xb_ld(&bar[XB_XCNT(j)]); sum += c; cnt += (c > 0u) ? 1u : 0u; mine = (j == x) ? c : mine; }
        if (sum == G) break;
        __builtin_amdgcn_s_sleep(1);
        if ((++sp & 255u) == 0u) { if (xb_ld(&bar[XB_TMO])) break; if (sp > XB_SPIN_CAP) { atomicAdd(&bar[XB_TMO], 1u); break; } }
    }
    nloc = mine > 0u ? mine : 1u; nx = cnt > 0u ? cnt : 1u;
}

__device__ __forceinline__ void xcd_barrier(const XcdBarrier& b) {
    asm volatile("s_waitcnt vmcnt(0)" ::: "memory");
    __syncthreads();
    if (threadIdx.x == 0) {
        unsigned* bar = b.bar;
        __builtin_amdgcn_s_waitcnt(0);
        unsigned nloc = b.st[0], nx = b.st[1];
        if (nloc == 0u) { xcd_barrier_complete(bar, b.x, nloc, nx); b.st[0] = nloc; b.st[1] = nx; }
        const unsigned old = xb_add(&bar[XB_XSUB(b.x)], 1u);
        const unsigned gen = old / nloc;
        if (old + 1u == (gen + 1u) * nloc) {
            __builtin_amdgcn_fence(__ATOMIC_RELEASE, "agent");
            asm volatile("s_waitcnt vmcnt(0)" ::: "memory");
            const unsigned og = xb_add(&bar[XB_TOP], 1u);
            const unsigned tg = og / nx;
            if (og + 1u == (tg + 1u) * nx) xb_add(&bar[XB_TOPGEN], 1u);
            else XB_SPIN(xb_ld(&bar[XB_TOPGEN]) == tg, bar);
            __builtin_amdgcn_fence(__ATOMIC_ACQUIRE, "agent");
            xb_add(&bar[XB_XGEN(b.x)], 1u);
            asm volatile("s_waitcnt vmcnt(0)" ::: "memory");
        } else {
            XB_SPIN(xb_ld(&bar[XB_XGEN(b.x)]) == gen, bar);
            __builtin_amdgcn_fence(__ATOMIC_ACQUIRE, "agent");
            asm volatile("s_waitcnt vmcnt(0)" ::: "memory");
        }
    }
    __syncthreads();
}


struct Args { const float* in[16]; float* out; unsigned char* ws; float inv_freq[16]; };

__device__ __forceinline__ void gmlp_unit(LAS unsigned char* lds, const bf16* VG, const bf16* U, const float* ssqv, const float* vnorm, const float* w_s, const float* b_s, bf16* AB, int chunk, int g, int tid) {
    const int lane = tid & 63, w = tid >> 6, fr = lane & 15, fq = lane >> 4;
    const int row0 = chunk * 128;
    LAS bf16* Vt = (LAS bf16*)lds;
    const int t = 16 * w + fr, nsteps = (16 * w + 15) / 32 + 1;
    const int srow = tid >> 4, ch = tid & 15;
    u32x4 x[4]; f32x4 sv0[4], sv1[4];
#pragma unroll
    for (int it = 0; it < 4; ++it) { const size_t r_ = (size_t)(row0 + srow + 32 * it);
        x[it] = *(const u32x4*)(VG + r_ * 512 + g * 128 + ch * 8); sv0[it] = *(const f32x4*)(ssqv + r_ * 8); sv1[it] = *(const f32x4*)(ssqv + r_ * 8 + 4); }
    const f32x4 g0 = *(const f32x4*)(vnorm + g * 128 + ch * 8), g1 = *(const f32x4*)(vnorm + g * 128 + ch * 8 + 4);
    f32x4 wa[4], wb[4];
#pragma unroll
    for (int st = 0; st < 4; ++st) if (st < nsteps) { const float* wp = w_s + ((size_t)(g * 128 + t) * 128 + 32 * st + 8 * fq); wa[st] = *(const f32x4*)wp; wb[st] = *(const f32x4*)(wp + 4); }
    const size_t tok = (size_t)(row0 + t);
    u32x2 uu[8];
#pragma unroll
    for (int c = 0; c < 8; ++c) uu[c] = *(const u32x2*)(U + tok * 512 + g * 128 + 16 * c + 4 * fq);
    const float bias = b_s[g * 128 + t];
    __builtin_amdgcn_sched_barrier(0);
#pragma unroll
    for (int it = 0; it < 4; ++it) { const int s = srow + 32 * it; const f32x4 sva = sv0[it] + sv1[it];
        const float rs = __builtin_amdgcn_rsqf(((sva[0] + sva[1]) + (sva[2] + sva[3])) * (1.0f / 512.0f) + 1e-6f);
        const unsigned xs[4] = {x[it].x, x[it].y, x[it].z, x[it].w};
#pragma unroll
        for (int e = 0; e < 4; ++e) { const float a = bf_lo(xs[e]) * rs * (e < 2 ? g0[2 * e] : g1[2 * e - 4]), b = bf_hi(xs[e]) * rs * (e < 2 ? g0[2 * e + 1] : g1[2 * e - 3]);
            const unsigned pk = pk2(a, b);
            Vt[(ch * 8 + 2 * e) * 136 + s] = (bf16)(pk & 0xffffu); Vt[(ch * 8 + 2 * e + 1) * 136 + s] = (bf16)(pk >> 16); } }
    __syncthreads();
    pg8::f32x4 acc[8];
#pragma unroll
    for (int c = 0; c < 8; ++c) acc[c] = (pg8::f32x4){0.f, 0.f, 0.f, 0.f};
#pragma unroll
    for (int st = 0; st < 4; ++st) if (st < nsteps) {
        const int s0 = 32 * st + 8 * fq;
        float wv[8] = {wa[st][0], wa[st][1], wa[st][2], wa[st][3], wb[st][0], wb[st][1], wb[st][2], wb[st][3]};
#pragma unroll
        for (int e = 0; e < 8; ++e) wv[e] = (s0 + e <= t) ? wv[e] : 0.f;
        u32x4 wpk; wpk.x = pk2(wv[0], wv[1]); wpk.y = pk2(wv[2], wv[3]); wpk.z = pk2(wv[4], wv[5]); wpk.w = pk2(wv[6], wv[7]);
        const bf16x8 wf = __builtin_bit_cast(bf16x8, wpk);
#pragma unroll
        for (int c = 0; c < 8; ++c) { const bf16x8 vf = *(const LAS bf16x8*)(Vt + (16 * c + fr) * 136 + 32 * st + 8 * fq);
            acc[c] = __builtin_amdgcn_mfma_f32_16x16x32_bf16(vf, wf, acc[c], 0, 0, 0); }
    }
#pragma unroll
    for (int c = 0; c < 8; ++c) {
        const float o0 = bf_lo(uu[c].x) * (acc[c][0] + bias), o1 = bf_hi(uu[c].x) * (acc[c][1] + bias), o2 = bf_lo(uu[c].y) * (acc[c][2] + bias), o3 = bf_hi(uu[c].y) * (acc[c][3] + bias);
        u32x2 o; o.x = pk2(o0, o1); o.y = pk2(o2, o3);
        *(u32x2*)(AB + tok * 1024 + g * 128 + 16 * c + 4 * fq) = o; }
    __syncthreads();
}

constexpr int AT_KP = 272, AT_VP = 320;
constexpr int AT_KB = 0, AT_VB = 2 * 64 * AT_KP, AT_MASK = AT_VB + 2 * 64 * AT_VP, AT_KM = AT_MASK + 512, AT_TILES = AT_KM + 8192, AT_MISC = AT_TILES + 320;
constexpr int AT_MO = 0, AT_ML = 65536;
__device__ __forceinline__ int crow16(int i, int h) { return (i & 3) + 8 * (i >> 2) + 4 * h; }
__device__ __forceinline__ bf16x8 pack8(float a0, float a1, float a2, float a3, float a4, float a5, float a6, float a7) {
    u32x4 p; p.x = pk2(a0, a1); p.y = pk2(a2, a3); p.z = pk2(a4, a5); p.w = pk2(a6, a7); return __builtin_bit_cast(bf16x8, p); }
__device__ __forceinline__ s16x4 tr_read(const LAS unsigned char* p) { return __builtin_bit_cast(s16x4, __builtin_amdgcn_ds_read_tr16_b64_v4i16((LAS v4i16_t*)p)); }

__device__ __forceinline__ void attn_unit(LAS unsigned char* lds, const bf16* Q, const bf16* K, const bf16* V, const float* ksum, bf16* AB, int b, int h, int j, int tid_in) {
    int tid = tid_in; asm volatile("" : "+v"(tid));
    const int lane = tid & 63, wave = tid >> 6, wq = wave & 3, kh = wave >> 2, r = lane & 31, hh = lane >> 5;
    const int qblk = j >> 1, q0 = 128 * j;
    const size_t tokbase = (size_t)b * SEQ_;
    const size_t hbase = (size_t)(b * 4 + h) * SEQ_;
    LAS float* km = (LAS float*)(lds + AT_KM);
    LAS unsigned* MASK = (LAS unsigned*)(lds + AT_MASK);
    LAS int* TILES = (LAS int*)(lds + AT_TILES);
    LAS unsigned* MISC = (LAS unsigned*)(lds + AT_MISC);
    for (int i = tid; i < qblk * 128; i += NTHR) km[i] = (ksum[(size_t)((b * 16 + (i >> 7)) * 2) * 512 + h * 128 + (i & 127)] + ksum[(size_t)((b * 16 + (i >> 7)) * 2 + 1) * 512 + h * 128 + (i & 127)]) * (1.0f / 256.0f);
    __syncthreads();
    {
        const int qi = tid >> 2, qt = tid & 3;
        const bf16* qp = Q + (hbase + q0 + qi) * 128 + qt * 32;
        float qv[32];
#pragma unroll
        for (int c = 0; c < 4; ++c) { const u32x4 x = *(const u32x4*)(qp + 8 * c);
            qv[8 * c + 0] = bf_lo(x.x); qv[8 * c + 1] = bf_hi(x.x); qv[8 * c + 2] = bf_lo(x.y); qv[8 * c + 3] = bf_hi(x.y);
            qv[8 * c + 4] = bf_lo(x.z); qv[8 * c + 5] = bf_hi(x.z); qv[8 * c + 6] = bf_lo(x.w); qv[8 * c + 7] = bf_hi(x.w); }
        float b0 = -3e38f, b1 = -3e38f, b2 = -3e38f; int i0 = -1, i1 = -1, i2 = -1;
        for (int n = 0; n < qblk; ++n) { const LAS float* kp = km + n * 128 + qt * 32; float s = 0.f;
#pragma unroll
            for (int d = 0; d < 32; ++d) s += qv[d] * kp[d];
            s += __shfl_xor(s, 1); s += __shfl_xor(s, 2);
            if (s > b0) { b2 = b1; i2 = i1; b1 = b0; i1 = i0; b0 = s; i0 = n; } else if (s > b1) { b2 = b1; i2 = i1; b1 = s; i1 = n; } else if (s > b2) { b2 = s; i2 = n; } }
        unsigned mk = 0; if (i0 >= 0) mk |= 1u << i0; if (i1 >= 0) mk |= 1u << i1; if (i2 >= 0) mk |= 1u << i2;
        if (qt == 0) MASK[qi] = mk;
    }
    __syncthreads();
    if (wave == 0) { unsigned o = MASK[lane] | MASK[lane + 64];
#pragma unroll
        for (int s = 1; s < 64; s <<= 1) o |= __shfl_xor(o, s);
        if (lane == 0) { int nt = 0;
            for (int n = 0; n < qblk; ++n) if ((o >> n) & 1u) for (int tt = 0; tt < 4; ++tt) TILES[nt++] = n * 256 + tt * 64;
            const int own = (j & 1) ? 4 : 2;
            for (int tt = 0; tt < own; ++tt) TILES[nt++] = qblk * 256 + tt * 64;
            MISC[0] = (unsigned)nt; } }
    __syncthreads();
    const int nt = __builtin_amdgcn_readfirstlane((int)MISC[0]);
    const unsigned mymask = MASK[32 * wq + r];
    const int qpos = q0 + 32 * wq + r;
    bf16x8 qf[8];
    { const bf16* qp = Q + (hbase + qpos) * 128 + hh * 8;
#pragma unroll
      for (int st = 0; st < 8; ++st) qf[st] = *(const bf16x8*)(qp + st * 16); }
    const int skey0 = tid >> 4, sch = tid & 15;
    const unsigned loff = (unsigned)(tid * 16);
    const char* Kg = (const char*)(K + hbase * 128);
    const char* Vg = (const char*)(V + hbase * 128);
    u32x4 kr0, kr1, vr0, vr1;
#define AT_LOADK(key0) do { const char* tb_ = Kg + (size_t)(key0) * 256; kr0 = *(const u32x4*)(tb_ + loff); kr1 = *(const u32x4*)(tb_ + 8192 + loff); } while (0)
#define AT_LOADV(key0) do { const char* tb_ = Vg + (size_t)(key0) * 256; vr0 = *(const u32x4*)(tb_ + loff); vr1 = *(const u32x4*)(tb_ + 8192 + loff); } while (0)
#define AT_STOREK(buf) do { *(LAS u32x4*)(lds + AT_KB + (buf) * 64 * AT_KP + skey0 * AT_KP + sch * 16) = kr0; *(LAS u32x4*)(lds + AT_KB + (buf) * 64 * AT_KP + (skey0 + 32) * AT_KP + sch * 16) = kr1; } while (0)
#define AT_STOREV(buf) do { *(LAS u32x4*)(lds + AT_VB + (buf) * 64 * AT_VP + skey0 * AT_VP + sch * 16) = vr0; *(LAS u32x4*)(lds + AT_VB + (buf) * 64 * AT_VP + (skey0 + 32) * AT_VP + sch * 16) = vr1; } while (0)
    AT_LOADK(__builtin_amdgcn_readfirstlane(TILES[0])); AT_LOADV(__builtin_amdgcn_readfirstlane(TILES[0])); AT_STOREK(0); AT_STOREV(0);
    __syncthreads();
    f32x16 O[4];
#pragma unroll
    for (int g = 0; g < 4; ++g)
#pragma unroll
        for (int i = 0; i < 16; ++i) O[g][i] = 0.f;
    float mrun = -1e30f, lrun = 0.f;
    const float sc = 0.08838834764831845f * 1.4426950408889634f;
    const int g1 = (lane >> 4) & 1, q_ = (lane & 15) >> 2, p_ = lane & 3;
    const int koff = (32 * kh + r) * AT_KP + hh * 16;
    const int voff = (32 * kh + 4 * hh + q_) * AT_VP + (16 * g1 + 4 * p_) * 2;
    for (int it = 0; it < nt; ++it) {
        const int key0 = __builtin_amdgcn_readfirstlane(TILES[it]);
        const bool more = it + 1 < nt;
        if (more) { const int kn = __builtin_amdgcn_readfirstlane(TILES[it + 1]); AT_LOADK(kn); AT_LOADV(kn); }
        const LAS unsigned char* Kb = lds + AT_KB + (it & 1) * 64 * AT_KP + koff;
        const LAS unsigned char* Vb = lds + AT_VB + (it & 1) * 64 * AT_VP + voff;
        bf16x8 kfr[8];
#pragma unroll
        for (int st = 0; st < 8; ++st) kfr[st] = *(const LAS bf16x8*)(Kb + st * 32);
        __builtin_amdgcn_sched_barrier(0);
        f32x16 p;
#pragma unroll
        for (int i = 0; i < 16; ++i) p[i] = 0.f;
#pragma unroll
        for (int st = 0; st < 8; ++st) p = __builtin_amdgcn_mfma_f32_32x32x16_bf16(kfr[st], qf[st], p, 0, 0, 0);
        s16x4 vlo[4], vhi[4];
#pragma unroll
        for (int g = 0; g < 4; ++g) { vlo[g] = tr_read(Vb + g * 64); vhi[g] = tr_read(Vb + g * 64 + 8 * AT_VP); }
        __builtin_amdgcn_sched_barrier(0);
        const int n = key0 >> 8; const bool own = (n == qblk);
        float ls = 0.f;
        if (own) {
#pragma unroll
            for (int i = 0; i < 16; ++i) { const int key = key0 + 32 * kh + crow16(i, hh); p[i] = (key <= qpos) ? p[i] : -__builtin_inff(); } }
        const float bias = (own || ((mymask >> n) & 1u)) ? 0.f : -__builtin_inff();
        {
            float mxr = fmaxf(fmaxf(p[0], p[1]), fmaxf(p[2], p[3]));
#pragma unroll
            for (int i = 4; i < 16; i += 4) mxr = fmaxf(mxr, fmaxf(fmaxf(p[i], p[i + 1]), fmaxf(p[i + 2], p[i + 3])));
            float mx = mxr * sc + bias; mx = fmaxf(mx, __shfl_xor(mx, 32));
            if (__any(mx > mrun + 8.0f)) { const float mnew = fmaxf(mrun, mx), alpha = __builtin_amdgcn_exp2f(mrun - mnew); mrun = mnew; lrun *= alpha;
#pragma unroll
                for (int g = 0; g < 4; ++g)
#pragma unroll
                    for (int i = 0; i < 16; ++i) O[g][i] *= alpha; }
            const float nb = bias - mrun;
#pragma unroll
            for (int i = 0; i < 16; ++i) { p[i] = __builtin_amdgcn_exp2f(__builtin_fmaf(p[i], sc, nb)); ls += p[i]; }
        }
        lrun += ls;
        const bf16x8 pb0 = pack8(p[0], p[1], p[2], p[3], p[4], p[5], p[6], p[7]), pb1 = pack8(p[8], p[9], p[10], p[11], p[12], p[13], p[14], p[15]);
        __builtin_amdgcn_sched_barrier(0);
        s16x4 wlo[4], whi[4];
#pragma unroll
        for (int g = 0; g < 4; ++g) { wlo[g] = tr_read(Vb + 16 * AT_VP + g * 64); whi[g] = tr_read(Vb + 16 * AT_VP + g * 64 + 8 * AT_VP); }
        __builtin_amdgcn_sched_barrier(0);
#pragma unroll
        for (int g = 0; g < 4; ++g) { const bf16x8 vf = {vlo[g][0], vlo[g][1], vlo[g][2], vlo[g][3], vhi[g][0], vhi[g][1], vhi[g][2], vhi[g][3]};
            O[g] = __builtin_amdgcn_mfma_f32_32x32x16_bf16(vf, pb0, O[g], 0, 0, 0); }
#pragma unroll
        for (int g = 0; g < 4; ++g) { const bf16x8 vf = {wlo[g][0], wlo[g][1], wlo[g][2], wlo[g][3], whi[g][0], whi[g][1], whi[g][2], whi[g][3]};
            O[g] = __builtin_amdgcn_mfma_f32_32x32x16_bf16(vf, pb1, O[g], 0, 0, 0); }
        if (more) { AT_STOREK((it + 1) & 1); AT_STOREV((it + 1) & 1); }
        __syncthreads();
    }
#undef AT_LOADK
#undef AT_LOADV
#undef AT_STOREK
#undef AT_STOREV
    lrun += __shfl_xor(lrun, 32);
    LAS float* MO = (LAS float*)(lds + AT_MO);
    LAS float* ML = (LAS float*)(lds + AT_ML);
    if (kh == 1) {
#pragma unroll
        for (int g = 0; g < 4; ++g)
#pragma unroll
            for (int i = 0; i < 16; ++i) MO[(wq * 128 + 32 * g + crow16(i, hh)) * 32 + r] = O[g][i];
        if (hh == 0) { ML[wq * 64 + r] = mrun; ML[wq * 64 + 32 + r] = lrun; }
    }
    __syncthreads();
    if (kh == 0) {
        const float m2 = ML[wq * 64 + r], l2 = ML[wq * 64 + 32 + r];
        const float mt = fmaxf(mrun, m2), a1 = __builtin_amdgcn_exp2f(mrun - mt), a2 = __builtin_amdgcn_exp2f(m2 - mt);
        const float inv = 1.0f / (lrun * a1 + l2 * a2);
        bf16* op = AB + (tokbase + qpos) * 1024 + 512 + h * 128;
#pragma unroll
        for (int g = 0; g < 4; ++g)
#pragma unroll
            for (int jj = 0; jj < 4; ++jj) { float o[4];
#pragma unroll
                for (int e = 0; e < 4; ++e) { const int i = 4 * jj + e; o[e] = (O[g][i] * a1 + MO[(wq * 128 + 32 * g + crow16(i, hh)) * 32 + r] * a2) * inv; }
                u32x2 w; w.x = pk2(o[0], o[1]); w.y = pk2(o[2], o[3]);
                *(u32x2*)(op + 32 * g + 8 * jj + 4 * hh) = w; }
    }
    __syncthreads();
}
constexpr int CV_GU = 16 * 176, CV_DN = 44 * 32, CV_FFN = CV_GU + CV_DN, CV_HI = 16 * 80, CV_HO = 16 * 32, CV_CI = 16 * 96, CV_CO = 16 * 32, CV_ALL = 4 * CV_FFN + CV_HI + CV_HO + CV_CI + CV_CO;
typedef const __attribute__((address_space(4))) Args* KArgP;
__device__ __forceinline__ void convert_items(KArgP ka, unsigned char* ws, int lo, int hi, int first, int stride, int lane) {
#define IN_(i) (ka->in[i])
#define WSP(T, off) ((T*)(ws + (off)))
    for (int it = lo + first; it < hi; it += stride) {
        int r = it;
        if (r < 4 * CV_FFN) { const int f = r / CV_FFN; r -= f * CV_FFN;
            bf16* GU = WSP(bf16, WS_WFFN + f * WFFN_STRIDE); bf16* DN = WSP(bf16, WS_WFFN + f * WFFN_STRIDE + WFFN_DN);
            if (r < CV_GU) { const int kb = r / 176, nb = r % 176, n0 = 32 * nb, tile = n0 >> 8, rr = n0 & 255;
                const float* src = (rr < 128 ? IN_(3) : IN_(4)) + (size_t)f * D_ * FF_; const int c0 = tile * 128 + (rr & 127);
                transpose_item(src, FF_, D_, c0, GU, n0, IN_(2) + f * D_, kb, lane);
            } else { r -= CV_GU; const int kb = r / 32, nb = r % 32;
                transpose_item(IN_(5) + (size_t)f * FF_ * D_, D_, FF_, 32 * nb, DN, 32 * nb, nullptr, kb, lane); }
            continue; }
        r -= 4 * CV_FFN;
        if (r < CV_HI) { const int kb = r / 80, nb = r % 80; transpose_item(IN_(7), 2560, D_, 32 * nb, WSP(bf16, WS_HYBIN), 32 * nb, IN_(6), kb, lane); continue; } r -= CV_HI;
        if (r < CV_HO) { const int kb = r / 32, nb = r % 32; transpose_item(IN_(11), D_, D_, 32 * nb, WSP(bf16, WS_HYBOUT), 32 * nb, nullptr, kb, lane); continue; } r -= CV_HO;
        if (r < CV_CI) { const int kb = r / 96, nb = r % 96, n0 = 32 * nb; int c0 = n0;
            if (n0 >= 1024) { const int t = (n0 - 1024) >> 8, rr = (n0 - 1024) & 255; c0 = (rr < 128 ? 1024 : 2048) + 128 * t + (rr & 127); }
            transpose_item(IN_(12), 3072, D_, c0, WSP(bf16, WS_CONVIN), n0, IN_(6) + D_, kb, lane); continue; } r -= CV_CI;
        { const int kb = r / 32, nb = r % 32; transpose_item(IN_(14), D_, D_, 32 * nb, WSP(bf16, WS_CONVOUT), 32 * nb, nullptr, kb, lane); }
    }
#undef IN_
#undef WSP
}
#define CONVERT_ON_IDLE(nunits, lo, hi) do { const int rem_ = (nunits) % G; if (bx >= rem_) { KA_FRESH(); LANE_FRESH(); convert_items(ka, ws, (lo), (hi), (bx - rem_) * NWAVES + wave, (G - rem_) * NWAVES, lane); } } while (0)

#ifndef PROBE_SYNC
#define PROBE_SYNC 0
#endif
#ifndef PROBE_P0
#define PROBE_P0 0
#endif
#ifndef PROBE_G1
#define PROBE_G1 0
#endif
#ifndef PROBE_ATT
#define PROBE_ATT 0
#endif
#ifndef PROBE_MIX
#define PROBE_MIX 0
#endif
#define GSYNC() do { KA_FRESH(); XcdBarrier xb_; xb_.bar = (unsigned*)(ws + WS_BAR); xb_.x = xb_xcc_id(); xb_.st = (volatile LAS unsigned*)(lds + LDS_CTL_OFF) + 8; xcd_barrier(xb_); if (PROBE_SYNC) xcd_barrier(xb_); } while (0)
__global__ void __launch_bounds__(NTHR, 2) fwd_megakernel(Args a) {
    extern __shared__ __attribute__((aligned(16))) unsigned char lds_raw[];
    cg::grid_group grid = cg::this_grid();
    LAS unsigned char* lds = (LAS unsigned char*)lds_raw;
    const int wave = __builtin_amdgcn_readfirstlane((int)threadIdx.x >> 6);
#define LANE_FRESH() unsigned ones_ = ~0u; asm volatile("" : "+s"(ones_)); const int lane = (int)__builtin_amdgcn_mbcnt_hi(ones_, __builtin_amdgcn_mbcnt_lo(ones_, 0u)); const int tid = (wave << 6) | lane; (void)tid
    const int G = gridDim.x, bx = blockIdx.x;
    const int vcu = (G % 8 == 0) ? (bx % 8) * (G / 8) + bx / 8 : bx;
    const int gw = vcu * NWAVES + wave, NGW = G * NWAVES, NGT = G * NTHR;
#define KA_FRESH() KArgP ka = (KArgP)__builtin_amdgcn_kernarg_segment_ptr(); asm volatile("" : "+s"(ka)); unsigned char* const ws = ka->ws; (void)ws
#define IN_(i) (ka->in[i])
#define WSP(T, off) ((T*)(ws + (off)))
    {
        KA_FRESH();
        if (ws == nullptr) grid.sync();
    }
    { LANE_FRESH(); if (tid < 64) ((LAS unsigned*)(lds + LDS_CTL_OFF))[tid] = 0u; }
    __syncthreads();
    { KA_FRESH(); (void)xcd_barrier_post((unsigned*)(ws + WS_BAR), (volatile LAS unsigned*)(lds + LDS_CTL_OFF) + 8); }

#pragma unroll 1
    for (int rep = 0; rep < 1 + PROBE_P0; ++rep) {
        KA_FRESH(); LANE_FRESH(); const int gt = bx * NTHR + tid;
        float* ssq = WSP(float, WS_SSQ); float* rope = WSP(float, WS_ROPE); bf16* XB = WSP(bf16, WS_XB);
        const float* x_in = IN_(0); const int* pos = (const int*)IN_(1);
        for (int i = gt; i < M_ * 16; i += NGT) { const int tok = i >> 4, f = i & 15;
            const float ang = (float)pos[tok] * ka->inv_freq[f];
            double t = (double)ang * 0.15915494309189535; t -= __builtin_rint(t); const float fr = (float)t;
            rope[(size_t)tok * 32 + f] = __builtin_amdgcn_cosf(fr); rope[(size_t)tok * 32 + 16 + f] = __builtin_amdgcn_sinf(fr); }
        for (int m = gw; m < M_; m += NGW) { const f32x4* xr = (const f32x4*)(x_in + (size_t)m * D_) + lane; f32x4 v[4]; float s = 0.f;
#pragma unroll
            for (int j = 0; j < 4; ++j) v[j] = __builtin_nontemporal_load(xr + 64 * j);
            __builtin_amdgcn_sched_barrier(0);
#pragma unroll
            for (int j = 0; j < 4; ++j) s += (v[j][0] * v[j][0] + v[j][1] * v[j][1]) + (v[j][2] * v[j][2] + v[j][3] * v[j][3]);
            s = wave_sum(s); if (lane < 4) ((f32x4*)(ssq + (size_t)m * 16))[lane] = (f32x4){lane == 0 ? s : 0.f, 0.f, 0.f, 0.f};
            u32x2* o8 = (u32x2*)(XB + (size_t)m * D_) + lane;
#pragma unroll
            for (int j = 0; j < 4; ++j) { u32x2 w; w.x = pk2(v[j][0], v[j][1]); w.y = pk2(v[j][2], v[j][3]); o8[64 * j] = w; } }
        convert_items(ka, ws, 0, CV_FFN, gw, NGW, lane);
    }
    GSYNC();

#pragma unroll 1
    for (int f = 0; f < 4; ++f) {
        const int ri = (f == 0) ? 0 : (f == 1) ? 2 : (f == 2) ? 3 : 5, wi = (f == 0) ? 1 : (f == 1) ? 3 : (f == 2) ? 4 : 6;
#pragma unroll 1
        for (int rep = 0; rep < 1 + PROBE_G1; ++rep) {
            KA_FRESH();
            pg8::Gemm g{WSP(bf16, WS_XB), WSP(bf16, WS_WFFN + f * WFFN_STRIDE), M_, 2 * FF_, D_}; pg8::StaticOrder S; S.init(M_, 2 * FF_, G, bx);
            pg8::EpiSwiGLU E{WSP(bf16, WS_ACT), WSP(float, WS_SSQ) + (size_t)ri * M_ * 16};
            pg8::gemm_phase<pg8::EpiSwiGLU, pg8::StaticOrder, true, true>(lds, g, S, E, wave);
        }
        if (f < 3) CONVERT_ON_IDLE(64 * 22, (f + 1) * CV_FFN, (f + 2) * CV_FFN);
        if (f == 0) CONVERT_ON_IDLE(64 * 22, 4 * CV_FFN, 4 * CV_FFN + CV_HI + CV_HO);
        GSYNC();
        {
            KA_FRESH();
            pg8::Gemm g{WSP(bf16, WS_ACT), WSP(bf16, WS_WFFN + f * WFFN_STRIDE + WFFN_DN), M_, D_, FF_}; pg8::StaticOrder S; S.init(M_, D_, G, bx);
            pg8::EpiResid E{WSP(bf16, WS_XB), WSP(float, WS_SSQ) + (size_t)wi * M_ * 16, 0.5f};
            pg8::gemm_phase<pg8::EpiResid, pg8::StaticOrder, true, true>(lds, g, S, E, wave);
        }
        GSYNC();
        if (f == 0) {
            {
                KA_FRESH();
                pg8::Gemm g{WSP(bf16, WS_XB), WSP(bf16, WS_HYBIN), M_, 2560, D_}; pg8::StaticOrder S; S.init(M_, 2560, G, bx);
                pg8::EpiHybIn E{WSP(bf16, WS_U), WSP(bf16, WS_VG), WSP(bf16, WS_Q), WSP(bf16, WS_K), WSP(bf16, WS_V), WSP(float, WS_SSQ) + (size_t)1 * M_ * 16, WSP(float, WS_SSQV), WSP(float, WS_KSUM), WSP(float, WS_ROPE)};
                pg8::gemm_phase<pg8::EpiHybIn, pg8::StaticOrder, true, true>(lds, g, S, E, wave);
            }
            CONVERT_ON_IDLE(64 * 10, 4 * CV_FFN + CV_HI + CV_HO, CV_ALL);
            GSYNC();
#pragma unroll 1
            for (int rep = 0; rep < 1 + PROBE_MIX; ++rep) { KA_FRESH(); LANE_FRESH(); const int tq = tid;
                for (int e = bx; e < 512; e += G) gmlp_unit(lds, WSP(bf16, WS_VG), WSP(bf16, WS_U), WSP(float, WS_SSQV), IN_(8), IN_(9), IN_(10), WSP(bf16, WS_AB), e >> 2, e & 3, tq);
                for (int e0 = bx; e0 < 256; e0 += G) {
                    const int xcd = (G == 256) ? (e0 & 7) : (e0 >> 5), c = (G == 256) ? (e0 >> 3) : (e0 & 31);
#pragma unroll 1
                    for (int ar = 0; ar < 2 * (1 + PROBE_ATT); ++ar) { const int bh = 2 * xcd + (ar & 1);
                        attn_unit(lds, WSP(bf16, WS_Q), WSP(bf16, WS_K), WSP(bf16, WS_V), WSP(float, WS_KSUM), WSP(bf16, WS_AB), bh >> 2, bh & 3, (ar & 1) ? 31 - c : c, tq); } } }
            GSYNC();
            {
                KA_FRESH();
                pg8::Gemm g{WSP(bf16, WS_AB), WSP(bf16, WS_HYBOUT), M_, D_, D_}; pg8::StaticOrder S; S.init(M_, D_, G, bx);
                pg8::EpiResid E{WSP(bf16, WS_XB), WSP(float, WS_SSQ) + (size_t)2 * M_ * 16, 1.0f};
                pg8::gemm_phase<pg8::EpiResid, pg8::StaticOrder, true, true>(lds, g, S, E, wave);
            }
            GSYNC();
        }
        if (f == 2) {
            {
                KA_FRESH();
                pg8::Gemm g{WSP(bf16, WS_XB), WSP(bf16, WS_CONVIN), M_, 3072, D_}; pg8::StaticOrder S; S.init(M_, 3072, G, bx);
                pg8::EpiConvIn E{WSP(bf16, WS_BG), WSP(bf16, WS_Z), WSP(float, WS_SSQ) + (size_t)4 * M_ * 16};
                pg8::gemm_phase<pg8::EpiConvIn, pg8::StaticOrder, true, true>(lds, g, S, E, wave);
            }
            GSYNC();
            {
                KA_FRESH();
                const bf16* Zb = WSP(bf16, WS_Z); const bf16* BGb = WSP(bf16, WS_BG); bf16* CMb = WSP(bf16, WS_CM); const float* conv_w = IN_(13);
                LANE_FRESH(); const int gt2 = bx * NTHR + tid;
                for (int i = gt2; i < M_ * 128; i += NGT) { const int tok = i >> 7, ch = i & 127, s = tok & (SEQ_ - 1);
                    const u32x4 z0 = *(const u32x4*)(Zb + (size_t)tok * 1024 + ch * 8);
                    u32x4 z1 = (u32x4){0u, 0u, 0u, 0u}, z2 = (u32x4){0u, 0u, 0u, 0u};
                    if (s >= 1) z1 = *(const u32x4*)(Zb + (size_t)(tok - 1) * 1024 + ch * 8);
                    if (s >= 2) z2 = *(const u32x4*)(Zb + (size_t)(tok - 2) * 1024 + ch * 8);
                    const u32x4 bg = *(const u32x4*)(BGb + (size_t)tok * 1024 + ch * 8);
                    __builtin_amdgcn_sched_barrier(0);
                    const unsigned a0[4] = {z0.x, z0.y, z0.z, z0.w}, a1[4] = {z1.x, z1.y, z1.z, z1.w}, a2[4] = {z2.x, z2.y, z2.z, z2.w}, ab[4] = {bg.x, bg.y, bg.z, bg.w};
                    unsigned o[4];
#pragma unroll
                    for (int e = 0; e < 4; ++e) { const int c = ch * 8 + 2 * e;
                        const float lo = bf_lo(ab[e]) * (conv_w[c] * bf_lo(a2[e]) + conv_w[1024 + c] * bf_lo(a1[e]) + conv_w[2048 + c] * bf_lo(a0[e]));
                        const float hi = bf_hi(ab[e]) * (conv_w[c + 1] * bf_hi(a2[e]) + conv_w[1024 + c + 1] * bf_hi(a1[e]) + conv_w[2048 + c + 1] * bf_hi(a0[e]));
                        o[e] = pk2(lo, hi); }
                    *(u32x4*)(CMb + (size_t)tok * 1024 + ch * 8) = (u32x4){o[0], o[1], o[2], o[3]}; }
            }
            GSYNC();
            {
                KA_FRESH();
                pg8::Gemm g{WSP(bf16, WS_CM), WSP(bf16, WS_CONVOUT), M_, D_, D_}; pg8::StaticOrder S; S.init(M_, D_, G, bx);
                pg8::EpiResid E{WSP(bf16, WS_XB), WSP(float, WS_SSQ) + (size_t)5 * M_ * 16, 1.0f};
                pg8::gemm_phase<pg8::EpiResid, pg8::StaticOrder, true, true>(lds, g, S, E, wave);
            }
            GSYNC();
        }
    }
    {
        KA_FRESH(); LANE_FRESH();
        float* X = ka->out; const bf16* XB = WSP(bf16, WS_XB); const float* ssq = WSP(float, WS_SSQ); const float* final_norm = IN_(15);
        for (int m = gw; m < M_; m += NGW) { const float rs = pg8::rstd_row(ssq + (size_t)6 * M_ * 16, m, 1.0f / 1024.0f);
#pragma unroll
            for (int j = 0; j < 2; ++j) { const u32x4 xb = *((const u32x4*)(XB + (size_t)m * D_) + lane + 64 * j);
                const f32x4 ga = *((const f32x4*)final_norm + 2 * (lane + 64 * j)), gb = *((const f32x4*)final_norm + 2 * (lane + 64 * j) + 1);
                f32x4 oa, ob; oa[0] = bf_lo(xb.x) * rs * ga[0]; oa[1] = bf_hi(xb.x) * rs * ga[1]; oa[2] = bf_lo(xb.y) * rs * ga[2]; oa[3] = bf_hi(xb.y) * rs * ga[3];
                ob[0] = bf_lo(xb.z) * rs * gb[0]; ob[1] = bf_hi(xb.z) * rs * gb[1]; ob[2] = bf_lo(xb.w) * rs * gb[2]; ob[3] = bf_hi(xb.w) * rs * gb[3];
                f32x4* o = (f32x4*)(X + (size_t)m * D_) + 2 * (lane + 64 * j); o[0] = oa; o[1] = ob; } }
    }
}

extern "C" void kernel_launch(void* const* d_in, const int* in_sizes, int n_in, void* d_out, int out_size, void* d_ws, size_t ws_size, hipStream_t stream) {
    static int grid = 0;
    if (grid == 0) {
        if (n_in != 16 || out_size != M_ * D_ || ws_size < WS_END) { fprintf(stderr, "kernel_launch: unexpected shapes (n_in %d out %d ws %zu)\n", n_in, out_size, ws_size); grid = -1; return; }
        int dev = 0, cus = 0, per_cu = 0;
        hipGetDevice(&dev); hipDeviceGetAttribute(&cus, hipDeviceAttributeMultiprocessorCount, dev);
        if (hipFuncSetAttribute((const void*)fwd_megakernel, hipFuncAttributeMaxDynamicSharedMemorySize, LDS_BYTES) != hipSuccess) { fprintf(stderr, "kernel_launch: hipFuncSetAttribute failed\n"); grid = -1; return; }
        if (hipOccupancyMaxActiveBlocksPerMultiprocessor(&per_cu, (const void*)fwd_megakernel, NTHR, LDS_BYTES) != hipSuccess || per_cu < 1) { fprintf(stderr, "kernel_launch: occupancy query says %d\n", per_cu); per_cu = 1; }
        (void)hipGetLastError();
        grid = cus * 1;
        if (grid > 256) grid = 256;
    }
    if (grid < 0) return;
    if (hipMemsetAsync((char*)d_ws + WS_BAR, 0, BAR_BYTES, stream) != hipSuccess) { fprintf(stderr, "kernel_launch: memset of barrier words failed\n"); return; }
    Args a{};
    for (int i = 0; i < 16; ++i) a.in[i] = (const float*)d_in[i];
    a.out = (float*)d_out; a.ws = (unsigned char*)d_ws;
    for (int i = 0; i < 16; ++i) a.inv_freq[i] = (float)pow(500000.0, -(double)i / 16.0);
    void* args[] = {&a};
    hipError_t e = hipLaunchCooperativeKernel((const void*)fwd_megakernel, dim3(grid), dim3(NTHR), args, LDS_BYTES, stream);
    if (e != hipSuccess) fprintf(stderr, "kernel_launch: cooperative launch failed: %s (grid %d)\n", hipGetErrorString(e), grid);
}
```

```cpp
#include <hip/hip_runtime.h>
#include <hip/hip_cooperative_groups.h>
#include <cstdio>
#include <cstdint>
#include <cmath>
namespace cg = cooperative_groups;

namespace pg8 {
#define PG8_LAS __attribute__((address_space(3)))
typedef unsigned short bf16_t;
typedef short bf16x8 __attribute__((ext_vector_type(8)));
typedef float f32x4 __attribute__((ext_vector_type(4)));
typedef unsigned u32x4 __attribute__((ext_vector_type(4)));
constexpr int BM = 256, BK = 64, HALF = 128, HTB = HALF * BK * 2  , STAGE_BYTES = 8 * HTB, NXCD = 8, WGM = 8;

__host__ __device__ __forceinline__ int lds_byte(int r, int c) { const int st = (r >> 4) * 2 + (c >> 5), rr = r & 15, cc = c & 31, ob = rr * 64 + cc * 2; return st * 1024 + (ob ^ (((ob >> 9) & 1) << 5)); }
__host__ __device__ __forceinline__ void stage_rc(int b, int& R, int& C) { const int st = b / 1024, sb = b % 1024, swz = sb ^ (((sb >> 9) & 1) << 5); R = (st >> 1) * 16 + swz / 64; C = (st & 1) * 32 + (swz % 64) / 2; }
__host__ __device__ __forceinline__ int perm32(int rho) { const int n = rho >> 4, i = rho & 15; return 8 * (i >> 2) + 4 * n + (i & 3); }

struct Unit { int pm, pn; };
struct Gemm { const bf16_t* A; const bf16_t* Bt; int M, N, K; };

struct StaticOrder {
    int nM, nN, nwg, G, c;
    __host__ __device__ void init(int M, int N, int G_, int c_) { nM = M / BM; nN = N / BM; nwg = nM * nN; G = G_; c = c_; }
    __host__ __device__ bool next(int i, Unit& u) const {
        const long L = (long)i * G + c; if (L >= nwg) return false;
        int wgid = (int)L; { const int q = nwg / NXCD, r = nwg % NXCD, xcd = wgid % NXCD, off = wgid / NXCD; wgid = (xcd < r ? xcd * (q + 1) : r * (q + 1) + (xcd - r) * q) + off; }
        const int nig = WGM * nN, gid = wgid / nig, fm = gid * WGM, gsz = (nM - fm) < WGM ? (nM - fm) : WGM;
        u.pm = fm + ((wgid % nig) % gsz); u.pn = (wgid % nig) / gsz; return true;
    }
    __device__ __forceinline__ void a_ready(const Unit&) const {}
    __device__ __forceinline__ void done(const Unit&) const {}
};
__device__ __forceinline__ unsigned cvt_pk_bf16(float lo, float hi) { unsigned r; asm volatile("v_cvt_pk_bf16_f32 %0, %1, %2" : "=v"(r) : "v"(lo), "v"(hi)); return r; }
typedef unsigned u32x2 __attribute__((ext_vector_type(2)));
constexpr float RMS_EPS_ = 1e-6f;
__device__ __forceinline__ float ssq_sum16(const float* ssq, int row) { const f32x4* p = (const f32x4*)(ssq + (size_t)row * 16); const f32x4 a = (p[0] + p[1]) + (p[2] + p[3]); return (a[0] + a[1]) + (a[2] + a[3]); }
__device__ __forceinline__ float rstd_row(const float* ssq, int row, float invn) { return __builtin_amdgcn_rsqf(ssq_sum16(ssq, row) * invn + RMS_EPS_); }
__device__ __forceinline__ float sigmoid_fast(float x) { return __builtin_amdgcn_rcpf(1.0f + __builtin_amdgcn_exp2f(-1.4426950408889634f * x)); }
__device__ __forceinline__ float gelu_tanh(float x) { const float y = 0.7978845608028654f * (x + 0.044715f * x * x * x); return x * sigmoid_fast(2.0f * y); }

__device__ __forceinline__ void rstd8(const float* ssq, int row0, int fq, float invn, float (&rs)[2][4]) {
    f32x4 part[2][4];
#pragma unroll
    for (int ai = 0; ai < 2; ++ai)
#pragma unroll
        for (int m = 0; m < 4; ++m) part[ai][m] = *(const f32x4*)(ssq + (size_t)(row0 + ai * HALF + m * 16) * 16 + 4 * fq);
#pragma unroll
    for (int ai = 0; ai < 2; ++ai)
#pragma unroll
        for (int m = 0; m < 4; ++m) { float t = (part[ai][m][0] + part[ai][m][1]) + (part[ai][m][2] + part[ai][m][3]); t += __shfl_xor(t, 16); t += __shfl_xor(t, 32);
            rs[ai][m] = __builtin_amdgcn_rsqf(t * invn + RMS_EPS_); }
}
constexpr int RS_TABLE_OFF = 131072 + 1024, RS_TABLE_UNITS = 14;
__device__ __forceinline__ void rs8_lds(PG8_LAS unsigned char* lds, int ui, int wr, int fr, float (&rs)[2][4]) {
    const PG8_LAS float* t = (const PG8_LAS float*)(lds + RS_TABLE_OFF) + ui * 256 + wr * 64 + fr;
#pragma unroll
    for (int ai = 0; ai < 2; ++ai)
#pragma unroll
        for (int m = 0; m < 4; ++m) rs[ai][m] = t[ai * HALF + m * 16];
}
struct EpiSwiGLU {
    static constexpr bool PERM = true, AFTER_DRAIN = false;
    bf16_t* O; PG8_LAS unsigned char* lds;
    __device__ __forceinline__ void operator()(const f32x4 (&acc)[2][2][4][2], const Unit& u, int wr, int wc, int fr, int fq, int ui) const {
        const int row0 = u.pm * BM + wr * 64 + fr, col0 = u.pn * 128 + wc * 32 + 8 * fq;
        float rsv[2][4]; rs8_lds(lds, ui, wr, fr, rsv);
#pragma unroll
        for (int ai = 0; ai < 2; ++ai)
#pragma unroll
            for (int m = 0; m < 4; ++m) { const int row = row0 + ai * HALF + m * 16; const float rs = rsv[ai][m];
                float h[8];
#pragma unroll
                for (int n = 0; n < 2; ++n)
#pragma unroll
                    for (int i = 0; i < 4; ++i) { const float g = acc[ai][0][m][n][i] * rs, up = acc[ai][1][m][n][i] * rs; h[4 * n + i] = g * sigmoid_fast(g) * up; }
                u32x4 w; w.x = cvt_pk_bf16(h[0], h[1]); w.y = cvt_pk_bf16(h[2], h[3]); w.z = cvt_pk_bf16(h[4], h[5]); w.w = cvt_pk_bf16(h[6], h[7]);
                *(u32x4*)(O + (size_t)row * 2816 + col0) = w; }
    }
};
struct EpiResid {
    static constexpr bool PERM = false, AFTER_DRAIN = false;
    bf16_t* XB; float* ssq_out; float scale;
    __device__ __forceinline__ void operator()(const f32x4 (&acc)[2][2][4][2], const Unit& u, int wr, int wc, int fr, int fq, int ui) const {
        const int row0 = u.pm * BM + wr * 64 + fr, col0 = u.pn * BM + wc * 32 + 4 * fq;
#pragma unroll
        for (int ai = 0; ai < 2; ++ai) {
            u32x2 b[4][2][2];
#pragma unroll
            for (int m = 0; m < 4; ++m)
#pragma unroll
                for (int bj = 0; bj < 2; ++bj)
#pragma unroll
                    for (int n = 0; n < 2; ++n) b[m][bj][n] = *(const u32x2*)(XB + (size_t)(row0 + ai * HALF + m * 16) * 1024 + col0 + bj * HALF + n * 16);
#pragma unroll
            for (int m = 0; m < 4; ++m) { const int row = row0 + ai * HALF + m * 16; float ss = 0.f;
#pragma unroll
                for (int bj = 0; bj < 2; ++bj)
#pragma unroll
                    for (int n = 0; n < 2; ++n) { const size_t off = (size_t)row * 1024 + col0 + bj * HALF + n * 16; const u32x2 bb = b[m][bj][n];
                        f32x4 v; v[0] = __builtin_bit_cast(float, bb.x << 16); v[1] = __builtin_bit_cast(float, bb.x & 0xffff0000u); v[2] = __builtin_bit_cast(float, bb.y << 16); v[3] = __builtin_bit_cast(float, bb.y & 0xffff0000u);
                        v = v + acc[ai][bj][m][n] * scale;
                        u32x2 w; w.x = cvt_pk_bf16(v[0], v[1]); w.y = cvt_pk_bf16(v[2], v[3]); *(u32x2*)(XB + off) = w;
                        ss += (v[0] * v[0] + v[1] * v[1]) + (v[2] * v[2] + v[3] * v[3]); }
                ss += __shfl_xor(ss, 16); ss += __shfl_xor(ss, 32);
                if (fq == 0) ssq_out[(size_t)row * 16 + u.pn * 4 + wc] = ss; }
            asm volatile("" ::: "memory"); }
    }
};
struct EpiHybIn {
    static constexpr bool PERM = false, AFTER_DRAIN = false;
    bf16_t *U, *VG, *Q, *K, *V; PG8_LAS unsigned char* lds; float* ssqv; float* ksum; const float* rope;
    __device__ __forceinline__ void operator()(const f32x4 (&acc)[2][2][4][2], const Unit& u, int wr, int wc, int fr, int fq, int ui) const {
        const int row0 = u.pm * BM + wr * 64 + fr, type = u.pn >> 1, cb = (u.pn & 1) * 256 + wc * 32 + 4 * fq;
        bf16_t* dst = type == 0 ? U : type == 1 ? VG : type == 2 ? Q : type == 3 ? K : V;
        float rsv[2][4]; rs8_lds(lds, ui, wr, fr, rsv);
        f32x4 ks[2][2];
#pragma unroll
        for (int bj = 0; bj < 2; ++bj)
#pragma unroll
            for (int n = 0; n < 2; ++n) ks[bj][n] = (f32x4){0.f, 0.f, 0.f, 0.f};
#pragma unroll
        for (int ai = 0; ai < 2; ++ai)
#pragma unroll
            for (int m = 0; m < 4; ++m) { const int row = row0 + ai * HALF + m * 16; const float rs = rsv[ai][m];
                f32x4 v[2][2];
#pragma unroll
                for (int bj = 0; bj < 2; ++bj)
#pragma unroll
                    for (int n = 0; n < 2; ++n) v[bj][n] = acc[ai][bj][m][n] * rs;
                if (type <= 1) { float ss = 0.f;
#pragma unroll
                    for (int bj = 0; bj < 2; ++bj)
#pragma unroll
                        for (int n = 0; n < 2; ++n)
#pragma unroll
                            for (int i = 0; i < 4; ++i) { const float g = gelu_tanh(v[bj][n][i]); v[bj][n][i] = g; ss += g * g; }
                    if (type == 1) { ss += __shfl_xor(ss, 16); ss += __shfl_xor(ss, 32); if (fq == 0) ssqv[(size_t)row * 8 + (u.pn & 1) * 4 + wc] = ss; } }
                if ((type == 2 || type == 3) && wc == 0) {
                    const f32x4 c4 = *(const f32x4*)(rope + (size_t)row * 32 + 4 * fq), s4 = *(const f32x4*)(rope + (size_t)row * 32 + 16 + 4 * fq);
#pragma unroll
                    for (int bj = 0; bj < 2; ++bj) { const f32x4 x1 = v[bj][0], x2 = v[bj][1]; v[bj][0] = x1 * c4 - x2 * s4; v[bj][1] = x2 * c4 + x1 * s4; } }
                if (type == 3) {
#pragma unroll
                    for (int bj = 0; bj < 2; ++bj)
#pragma unroll
                        for (int n = 0; n < 2; ++n) ks[bj][n] += v[bj][n]; }
#pragma unroll
                for (int bj = 0; bj < 2; ++bj)
#pragma unroll
                    for (int n = 0; n < 2; ++n) { u32x2 w; w.x = cvt_pk_bf16(v[bj][n][0], v[bj][n][1]); w.y = cvt_pk_bf16(v[bj][n][2], v[bj][n][3]);
                        if (type <= 1) *(u32x2*)(dst + (size_t)row * 512 + cb + bj * HALF + n * 16) = w;
                        else *(u32x2*)(dst + ((size_t)((row >> 12) * 4 + (u.pn & 1) * 2 + bj) * 4096 + (row & 4095)) * 128 + wc * 32 + 4 * fq + n * 16) = w;   } }
        if (type == 3) {
#pragma unroll
            for (int bj = 0; bj < 2; ++bj)
#pragma unroll
                for (int n = 0; n < 2; ++n)
#pragma unroll
                    for (int i = 0; i < 4; ++i) { float s = ks[bj][n][i]; s += __shfl_xor(s, 1); s += __shfl_xor(s, 2); s += __shfl_xor(s, 4); s += __shfl_xor(s, 8);
                        if (fr == 0) ksum[(size_t)(u.pm * 2 + wr) * 512 + cb + bj * HALF + n * 16 + i] = s; } }
    }
};
struct EpiConvIn {
    static constexpr bool PERM = true, AFTER_DRAIN = false;
    bf16_t *BG, *Z; PG8_LAS unsigned char* lds;
    __device__ __forceinline__ void operator()(const f32x4 (&acc)[2][2][4][2], const Unit& u, int wr, int wc, int fr, int fq, int ui) const {
        const int row0 = u.pm * BM + wr * 64 + fr;
        float rsv[2][4]; rs8_lds(lds, ui, wr, fr, rsv);
#pragma unroll
        for (int ai = 0; ai < 2; ++ai)
#pragma unroll
            for (int m = 0; m < 4; ++m) { const int row = row0 + ai * HALF + m * 16; const float rs = rsv[ai][m];
                if (u.pn < 4) {
#pragma unroll
                    for (int bj = 0; bj < 2; ++bj) { const f32x4 a = acc[ai][bj][m][0] * rs, b = acc[ai][bj][m][1] * rs;
                        u32x4 w; w.x = cvt_pk_bf16(a[0], a[1]); w.y = cvt_pk_bf16(a[2], a[3]); w.z = cvt_pk_bf16(b[0], b[1]); w.w = cvt_pk_bf16(b[2], b[3]);
                        *(u32x4*)(BG + (size_t)row * 1024 + u.pn * 256 + bj * HALF + wc * 32 + 8 * fq) = w; }
                } else { const float r2 = rs * rs; const f32x4 a = acc[ai][0][m][0] * acc[ai][1][m][0] * r2, b = acc[ai][0][m][1] * acc[ai][1][m][1] * r2;
                    u32x4 w; w.x = cvt_pk_bf16(a[0], a[1]); w.y = cvt_pk_bf16(a[2], a[3]); w.z = cvt_pk_bf16(b[0], b[1]); w.w = cvt_pk_bf16(b[2], b[3]);
                    *(u32x4*)(Z + (size_t)row * 1024 + (u.pn - 4) * 128 + wc * 32 + 8 * fq) = w; } }
    }
};
template <class Epi, class Sched, bool ALIGN_EPI = false, bool SP2 = false>
__device__ __forceinline__ void gemm_phase(PG8_LAS unsigned char* lds, const Gemm g, const Sched& S, const Epi& E, const int wave_s) {
    unsigned ones_o = ~0u; asm volatile("" : "+s"(ones_o)); const int tid_o = (int)__builtin_amdgcn_mbcnt_hi(ones_o, __builtin_amdgcn_mbcnt_lo(ones_o, 0u)) | (wave_s << 6);
    const int tid = tid_o, wid = __builtin_amdgcn_readfirstlane(tid >> 6), lane = tid & 63, wr = wid >> 2, wc = wid & 3, fr = lane & 15, fq = lane >> 4;
    const int K = g.K, nt = K / BK;
    unsigned voffA[2], voffB[2];
#pragma unroll
    for (int i = 0; i < 2; ++i) { int R, C; stage_rc(tid * 16 + i * 8192, R, C); const int Rb = Epi::PERM ? ((R & ~31) + perm32(R & 31)) : R;
        voffA[i] = (unsigned)(R * K + C) * 2u; voffB[i] = (unsigned)(Rb * K + C) * 2u; }
    const size_t kstep = (size_t)(BK * 2);
    const size_t hstep = (size_t)HALF * K * 2;
    const size_t tstep = 2 * hstep;
    const unsigned ldsw = (unsigned)wid * 1024u;
    const int aoff = lds_byte(wr * 64 + fr, fq * 8), boff = lds_byte(wc * 32 + fr, fq * 8);
#define PG8_SA(b, h) (((b) * 2 + (h)) * HTB)
#define PG8_SB(b, h) ((4 + (b) * 2 + (h)) * HTB)
#define PG8_STAGE(bufoff, gbase, voff) do { _Pragma("unroll") for (int _i = 0; _i < 2; ++_i) \
        __builtin_amdgcn_global_load_lds((const unsigned*)((const char*)(gbase) + (voff)[_i]), (PG8_LAS unsigned*)(lds + (bufoff) + ldsw + _i * 8192), 16, 0, 0); } while (0)
#define PG8_LDA(dst, b, h) do { _Pragma("unroll") for (int m = 0; m < 4; ++m) _Pragma("unroll") for (int k = 0; k < 2; ++k) dst[m][k] = *(const PG8_LAS bf16x8*)(lds + PG8_SA(b, h) + aoff + m * 2048 + k * 1024); } while (0)
#define PG8_LDB(dst, b, h) do { _Pragma("unroll") for (int n = 0; n < 2; ++n) _Pragma("unroll") for (int k = 0; k < 2; ++k) dst[n][k] = *(const PG8_LAS bf16x8*)(lds + PG8_SB(b, h) + boff + n * 2048 + k * 1024); } while (0)
#define PG8_MMA(ai, bj, At, Bt) do { __builtin_amdgcn_s_setprio(1); _Pragma("unroll") for (int m = 0; m < 4; ++m) _Pragma("unroll") for (int n = 0; n < 2; ++n) _Pragma("unroll") for (int k = 0; k < 2; ++k) \
        acc[ai][bj][m][n] = __builtin_amdgcn_mfma_f32_16x16x32_bf16(Bt[n][k], At[m][k], acc[ai][bj][m][n], 0, 0, 0); __builtin_amdgcn_s_setprio(0); } while (0)
#define PG8_WAIT_V(n) asm volatile("s_waitcnt vmcnt(" #n ")" ::: "memory")
#define PG8_WAIT_L(n) asm volatile("s_waitcnt lgkmcnt(" #n ")" ::: "memory")
#define PG8_BAR __builtin_amdgcn_s_barrier()
#define PG8_SCHED __builtin_amdgcn_sched_barrier(0)
    Unit cur, nxt; int ui = 0;
    if (!S.next(0, cur)) return;
    f32x4 acc[2][2][4][2];
#pragma unroll
    for (int a = 0; a < 2; ++a)
#pragma unroll
        for (int b = 0; b < 2; ++b)
#pragma unroll
            for (int m = 0; m < 4; ++m)
#pragma unroll
                for (int n = 0; n < 2; ++n) acc[a][b][m][n] = (f32x4){0.f, 0.f, 0.f, 0.f};
    bf16x8 At[4][2], B0[2][2], B1[2][2];
    const char* cA = (const char*)g.A + (size_t)cur.pm * tstep; const char* cB = (const char*)g.Bt + (size_t)cur.pn * tstep;
    S.a_ready(cur);
    if constexpr (SP2) {
        PG8_STAGE(PG8_SB(0, 0), cB, voffB); PG8_STAGE(PG8_SB(0, 1), cB + hstep, voffB); PG8_STAGE(PG8_SA(0, 0), cA, voffA); PG8_STAGE(PG8_SA(0, 1), cA + hstep, voffA);
        if (wr == 1) PG8_BAR;
        PG8_WAIT_V(2); PG8_BAR;
        PG8_STAGE(PG8_SB(1, 0), cB + kstep, voffB); PG8_STAGE(PG8_SA(1, 0), cA + kstep, voffA); PG8_STAGE(PG8_SB(1, 1), cB + hstep + kstep, voffB);
        PG8_WAIT_V(6); PG8_BAR;
    } else {
        PG8_STAGE(PG8_SB(0, 0), cB, voffB); PG8_STAGE(PG8_SA(0, 0), cA, voffA); PG8_STAGE(PG8_SB(0, 1), cB + hstep, voffB); PG8_STAGE(PG8_SA(0, 1), cA + hstep, voffA);
        if (wr == 1) PG8_BAR;
        PG8_WAIT_V(4); PG8_BAR;
        PG8_STAGE(PG8_SB(1, 0), cB + kstep, voffB); PG8_STAGE(PG8_SA(1, 0), cA + kstep, voffA); PG8_STAGE(PG8_SB(1, 1), cB + hstep + kstep, voffB);
        PG8_WAIT_V(6); PG8_BAR;
    }
    for (;;) {
        const bool has_next = S.next(ui + 1, nxt);
        const char* nA = has_next ? (const char*)g.A + (size_t)nxt.pm * tstep : cA; const char* nB = has_next ? (const char*)g.Bt + (size_t)nxt.pn * tstep : cB;
        for (int t = 0; t < nt; t += 2) {
            const bool last = (t == nt - 2);
            const char* a1 = cA + (size_t)(t + 1) * kstep;
            const char* a2 = last ? nA : cA + (size_t)(t + 2) * kstep; const char* b2 = last ? nB : cB + (size_t)(t + 2) * kstep;
            const char* a3 = a2 + kstep; const char* b3 = b2 + kstep;
            if (last && has_next) S.a_ready(nxt);
            if constexpr (SP2) {
            PG8_LDB(B0, 0, 0); PG8_LDB(B1, 0, 1); PG8_SCHED; PG8_LDA(At, 0, 0); PG8_STAGE(PG8_SA(1, 1), a1 + hstep, voffA);
            PG8_WAIT_V(8); PG8_WAIT_L(0); PG8_BAR; PG8_MMA(0, 0, At, B0); PG8_MMA(0, 1, At, B1); PG8_BAR; PG8_SCHED;
            PG8_LDA(At, 0, 1); PG8_STAGE(PG8_SB(0, 0), b2, voffB); PG8_STAGE(PG8_SB(0, 1), b2 + hstep, voffB); PG8_STAGE(PG8_SA(0, 0), a2, voffA);
            PG8_WAIT_V(8); PG8_WAIT_L(0); PG8_BAR; PG8_MMA(1, 0, At, B0); PG8_MMA(1, 1, At, B1); PG8_BAR; PG8_SCHED;
            PG8_LDB(B0, 1, 0); PG8_LDB(B1, 1, 1); PG8_SCHED; PG8_LDA(At, 1, 0); PG8_STAGE(PG8_SA(0, 1), a2 + hstep, voffA);
            PG8_WAIT_V(8); PG8_WAIT_L(0); PG8_BAR; PG8_MMA(0, 0, At, B0); PG8_MMA(0, 1, At, B1); PG8_BAR; PG8_SCHED;
            PG8_LDA(At, 1, 1); PG8_STAGE(PG8_SB(1, 0), b3, voffB); PG8_STAGE(PG8_SB(1, 1), b3 + hstep, voffB); PG8_STAGE(PG8_SA(1, 0), a3, voffA);
            PG8_WAIT_V(8); PG8_WAIT_L(0); PG8_BAR; PG8_MMA(1, 0, At, B0); PG8_MMA(1, 1, At, B1); PG8_BAR; PG8_SCHED;
            } else {
            PG8_LDB(B0, 0, 0); PG8_SCHED; PG8_LDA(At, 0, 0); PG8_STAGE(PG8_SA(1, 1), a1 + hstep, voffA);
            PG8_WAIT_L(8); PG8_BAR; PG8_WAIT_L(0); PG8_MMA(0, 0, At, B0); PG8_BAR; PG8_SCHED;
            PG8_LDB(B1, 0, 1); PG8_STAGE(PG8_SB(0, 0), b2, voffB);
            PG8_BAR; PG8_WAIT_L(0); PG8_MMA(0, 1, At, B1); PG8_BAR;
            PG8_LDA(At, 0, 1); PG8_STAGE(PG8_SA(0, 0), a2, voffA);
            PG8_BAR; PG8_WAIT_L(0); PG8_MMA(1, 0, At, B0); PG8_BAR; PG8_SCHED;
            PG8_STAGE(PG8_SB(0, 1), b2 + hstep, voffB);
            PG8_WAIT_V(6); PG8_BAR; PG8_MMA(1, 1, At, B1); PG8_BAR;
            PG8_LDB(B0, 1, 0); PG8_SCHED; PG8_LDA(At, 1, 0); PG8_STAGE(PG8_SA(0, 1), a2 + hstep, voffA);
            PG8_WAIT_L(8); PG8_BAR; PG8_WAIT_L(0); PG8_MMA(0, 0, At, B0); PG8_BAR; PG8_SCHED;
            PG8_LDB(B1, 1, 1); PG8_STAGE(PG8_SB(1, 0), b3, voffB);
            PG8_BAR; PG8_WAIT_L(0); PG8_MMA(0, 1, At, B1); PG8_BAR;
            PG8_LDA(At, 1, 1); PG8_STAGE(PG8_SA(1, 0), a3, voffA);
            PG8_BAR; PG8_WAIT_L(0); PG8_MMA(1, 0, At, B0); PG8_BAR; PG8_SCHED;
            PG8_STAGE(PG8_SB(1, 1), b3 + hstep, voffB);
            PG8_WAIT_V(6); PG8_BAR; PG8_MMA(1, 1, At, B1); PG8_BAR;
            }
        }
        if constexpr (ALIGN_EPI) { if (wr == 0) PG8_BAR; }
        if constexpr (!Epi::AFTER_DRAIN) { E(acc, cur, wr, wc, fr, fq, ui); S.done(cur); }
        if (!has_next) break;
#pragma unroll
        for (int a = 0; a < 2; ++a)
#pragma unroll
            for (int b = 0; b < 2; ++b)
#pragma unroll
                for (int m = 0; m < 4; ++m)
#pragma unroll
                    for (int n = 0; n < 2; ++n) acc[a][b][m][n] = (f32x4){0.f, 0.f, 0.f, 0.f};
        cur = nxt; cA = nA; cB = nB; ++ui;
        if constexpr (ALIGN_EPI) { if (wr == 1) PG8_BAR; }
    }
    PG8_WAIT_V(0);
    if constexpr (!ALIGN_EPI) { if (wr == 0) PG8_BAR; }
    PG8_BAR;
    if constexpr (Epi::AFTER_DRAIN) { E.fused(acc, cur, wr, wc, fr, fq, lds, wid, lane); S.done(cur); }
#undef PG8_SA
#undef PG8_SB
#undef PG8_STAGE
#undef PG8_LDA
#undef PG8_LDB
#undef PG8_MMA
#undef PG8_WAIT_V
#undef PG8_WAIT_L
#undef PG8_BAR
#undef PG8_SCHED
}
}
#define LAS __attribute__((address_space(3)))
typedef unsigned short bf16;
typedef float f32x4 __attribute__((ext_vector_type(4)));
typedef float f32x16 __attribute__((ext_vector_type(16)));
typedef short bf16x8 __attribute__((ext_vector_type(8)));
typedef short s16x4 __attribute__((ext_vector_type(4)));
typedef unsigned u32x4 __attribute__((ext_vector_type(4)));
typedef unsigned u32x2 __attribute__((ext_vector_type(2)));
typedef short v4i16_t __attribute__((ext_vector_type(4)));

constexpr int M_ = 16384, D_ = 1024, FF_ = 2816, SEQ_ = 4096, NWAVES = 8, NTHR = 512;
constexpr int LDS_BYTES = 147456;
constexpr size_t MiB = 1u << 20;
constexpr size_t WS_SSQ = 232 * MiB;
constexpr size_t WS_SSQV = 240 * MiB;
constexpr size_t WS_KSUM = 241 * MiB;
constexpr size_t WS_ROPE = 1 * MiB;
constexpr size_t WS_BAR = 3 * MiB, BAR_BYTES = 16384;
constexpr int LDS_CTL_OFF = 131072;
constexpr size_t WS_WFFN = 4 * MiB, WFFN_STRIDE = 17 * MiB, WFFN_DN = 11 * MiB;
constexpr size_t WS_HYBIN = 72 * MiB, WS_HYBOUT = 77 * MiB, WS_CONVIN = 79 * MiB, WS_CONVOUT = 85 * MiB;
constexpr size_t WS_XB = 88 * MiB, WS_ACT = 120 * MiB;
constexpr size_t WS_U = 120 * MiB, WS_VG = 136 * MiB, WS_Q = 152 * MiB, WS_K = 168 * MiB, WS_V = 184 * MiB, WS_AB = 200 * MiB;
constexpr size_t WS_BG = 120 * MiB, WS_Z = 152 * MiB, WS_CM = 184 * MiB;
constexpr size_t WS_END = 242 * MiB;

__device__ __forceinline__ unsigned f2bf(float f) { unsigned u = __builtin_bit_cast(unsigned, f); return (u + 0x7fffu + ((u >> 16) & 1u)) >> 16; }
typedef __bf16 hw_bf16x2 __attribute__((ext_vector_type(2)));
typedef float hw_f32x2 __attribute__((ext_vector_type(2)));
__device__ __forceinline__ unsigned pk2(float lo, float hi) { const hw_f32x2 v = {lo, hi}; const hw_bf16x2 b = __builtin_convertvector(v, hw_bf16x2); return __builtin_bit_cast(unsigned, b); }
__device__ __forceinline__ float bf_lo(unsigned w) { return __builtin_bit_cast(float, w << 16); }
__device__ __forceinline__ float bf_hi(unsigned w) { return __builtin_bit_cast(float, w & 0xffff0000u); }
__device__ __forceinline__ float wave_sum(float v) {
#pragma unroll
    for (int o = 1; o < 64; o <<= 1) v += __shfl_xor(v, o);
    return v;
}
#define LDS_WAIT() asm volatile("s_waitcnt lgkmcnt(0)" ::: "memory")

__device__ __forceinline__ void transpose_item(const float* W, int ldw, int K, int c0, bf16* WT, int n_dst0, const float* gain, int kb, int lane) {
    const int n4 = lane & 7, kq = lane >> 3, k0 = 64 * kb + 8 * kq;
    const float* src = W + (size_t)k0 * ldw + c0 + 4 * n4;
    f32x4 v[8];
#pragma unroll
    for (int i = 0; i < 8; ++i) v[i] = __builtin_nontemporal_load((const f32x4*)(src + (size_t)i * ldw));
    __builtin_amdgcn_sched_barrier(0);
    if (gain) { const f32x4 g0 = *(const f32x4*)(gain + k0), g1 = *(const f32x4*)(gain + k0 + 4);
#pragma unroll
        for (int i = 0; i < 4; ++i) { v[i] = v[i] * g0[i]; v[4 + i] = v[4 + i] * g1[i]; } }
#pragma unroll
    for (int jn = 0; jn < 4; ++jn) { u32x4 o; o.x = pk2(v[0][jn], v[1][jn]); o.y = pk2(v[2][jn], v[3][jn]); o.z = pk2(v[4][jn], v[5][jn]); o.w = pk2(v[6][jn], v[7][jn]);
        *(u32x4*)(WT + (size_t)(n_dst0 + 4 * n4 + jn) * K + k0) = o; }
}

#define XB_TMO      128
#define XB_XCNT(j)  (256  + 64 * (j))
#define XB_XSUB(j)  (1280 + 64 * (j))
#define XB_XGEN(j)  (2304 + 64 * (j))
#define XB_TOP      3328
#define XB_TOPGEN   3392
#define XCD_BAR_WORDS 3456
#define XB_SPIN_CAP (1u << 18)

__device__ __forceinline__ unsigned xb_ld(unsigned* p)              { return __hip_atomic_load(p, __ATOMIC_RELAXED, __HIP_MEMORY_SCOPE_AGENT); }
__device__ __forceinline__ unsigned xb_add(unsigned* p, unsigned v) { return __hip_atomic_fetch_add(p, v, __ATOMIC_RELAXED, __HIP_MEMORY_SCOPE_AGENT); }
__device__ __forceinline__ unsigned xb_xcc_id() { return (unsigned)__builtin_amdgcn_s_getreg((3 << 11) | 20) & 0xFu; }
#define XB_SPIN(cond, bar) do { unsigned _sp = 0; while (cond) { __builtin_amdgcn_s_sleep(1); \
    if ((++_sp & 255u) == 0u) { if (xb_ld(&(bar)[XB_TMO])) break; if (_sp > XB_SPIN_CAP) { atomicAdd(&(bar)[XB_TMO], 1u); break; } } } } while (0)

struct XcdBarrier {
    unsigned* bar; unsigned x;
    volatile LAS unsigned* st;
};

__device__ __forceinline__ XcdBarrier xcd_barrier_post(unsigned* bar, volatile LAS unsigned* st) {
    XcdBarrier b; b.bar = bar; b.x = xb_xcc_id(); b.st = st;
    if (threadIdx.x == 0) (void)xb_add(&bar[XB_XCNT(b.x)], 1u);
    return b;
}
__device__ __forceinline__ void xcd_barrier_complete(unsigned* bar, unsigned x, unsigned& nloc, unsigned& nx) {
    const unsigned G = gridDim.x * gridDim.y * gridDim.z;
    unsigned sum, cnt, mine, sp = 0u;
    for (;;) {
        sum = 0u; cnt = 0u; mine = 0u;
#pragma unroll
        for (unsigned j = 0; j < 16; ++j) { const unsigned c = xb_ld(&bar[XB_XCNT(j)]); sum += c; cnt += (c > 0u) ? 1u : 0u; mine = (j == x) ? c : mine; }
        if (sum == G) break;
        __builtin_amdgcn_s_sleep(1);
        if ((++sp & 255u) == 0u) { if (xb_ld(&bar[XB_TMO])) break; if (sp > XB_SPIN_CAP) { atomicAdd(&bar[XB_TMO], 1u); break; } }
    }
    nloc = mine > 0u ? mine : 1u; nx = cnt > 0u ? cnt : 1u;
}

__device__ __forceinline__ void xcd_barrier(const XcdBarrier& b) {
    asm volatile("s_waitcnt vmcnt(0)" ::: "memory");
    __syncthreads();
    if (threadIdx.x == 0) {
        unsigned* bar = b.bar;
        __builtin_amdgcn_s_waitcnt(0);
        unsigned nloc = b.st[0], nx = b.st[1];
        if (nloc == 0u) { xcd_barrier_complete(bar, b.x, nloc, nx); b.st[0] = nloc; b.st[1] = nx; }
        const unsigned old = xb_add(&bar[XB_XSUB(b.x)], 1u);
        const unsigned gen = old / nloc;
        if (old + 1u == (gen + 1u) * nloc) {
            __builtin_amdgcn_fence(__ATOMIC_RELEASE, "agent");
            asm volatile("s_waitcnt vmcnt(0)" ::: "memory");
            const unsigned og = xb_add(&bar[XB_TOP], 1u);
            const unsigned tg = og / nx;
            if (og + 1u == (tg + 1u) * nx) xb_add(&bar[XB_TOPGEN], 1u);
            else XB_SPIN(xb_ld(&bar[XB_TOPGEN]) == tg, bar);
            __builtin_amdgcn_fence(__ATOMIC_ACQUIRE, "agent");
            xb_add(&bar[XB_XGEN(b.x)], 1u);
            asm volatile("s_waitcnt vmcnt(0)" ::: "memory");
        } else {
            XB_SPIN(xb_ld(&bar[XB_XGEN(b.x)]) == gen, bar);
            __builtin_amdgcn_fence(__ATOMIC_ACQUIRE, "agent");
            asm volatile("s_waitcnt vmcnt(0)" ::: "memory");
        }
    }
    __syncthreads();
}


struct Args { const float* in[16]; float* out; unsigned char* ws; float inv_freq[16]; };

__device__ __forceinline__ void gmlp_unit(LAS unsigned char* lds, const bf16* VG, const bf16* U, const float* ssqv, const float* vnorm, const float* w_s, const float* b_s, bf16* AB, int chunk, int g, int tid) {
    const int lane = tid & 63, w = tid >> 6, fr = lane & 15, fq = lane >> 4;
    const int row0 = chunk * 128;
    LAS bf16* Vt = (LAS bf16*)lds;
    const int t = 16 * w + fr, nsteps = (16 * w + 15) / 32 + 1;
    const int srow = tid >> 4, ch = tid & 15;
    u32x4 x[4]; f32x4 sv0[4], sv1[4];
#pragma unroll
    for (int it = 0; it < 4; ++it) { const size_t r_ = (size_t)(row0 + srow + 32 * it);
        x[it] = *(const u32x4*)(VG + r_ * 512 + g * 128 + ch * 8); sv0[it] = *(const f32x4*)(ssqv + r_ * 8); sv1[it] = *(const f32x4*)(ssqv + r_ * 8 + 4); }
    const f32x4 g0 = *(const f32x4*)(vnorm + g * 128 + ch * 8), g1 = *(const f32x4*)(vnorm + g * 128 + ch * 8 + 4);
    f32x4 wa[4], wb[4];
#pragma unroll
    for (int st = 0; st < 4; ++st) if (st < nsteps) { const float* wp = w_s + ((size_t)(g * 128 + t) * 128 + 32 * st + 8 * fq); wa[st] = *(const f32x4*)wp; wb[st] = *(const f32x4*)(wp + 4); }
    const size_t tok = (size_t)(row0 + t);
    u32x2 uu[8];
#pragma unroll
    for (int c = 0; c < 8; ++c) uu[c] = *(const u32x2*)(U + tok * 512 + g * 128 + 16 * c + 4 * fq);
    const float bias = b_s[g * 128 + t];
    __builtin_amdgcn_sched_barrier(0);
#pragma unroll
    for (int it = 0; it < 4; ++it) { const int s = srow + 32 * it; const f32x4 sva = sv0[it] + sv1[it];
        const float rs = __builtin_amdgcn_rsqf(((sva[0] + sva[1]) + (sva[2] + sva[3])) * (1.0f / 512.0f) + 1e-6f);
        const unsigned xs[4] = {x[it].x, x[it].y, x[it].z, x[it].w};
#pragma unroll
        for (int e = 0; e < 4; ++e) { const float a = bf_lo(xs[e]) * rs * (e < 2 ? g0[2 * e] : g1[2 * e - 4]), b = bf_hi(xs[e]) * rs * (e < 2 ? g0[2 * e + 1] : g1[2 * e - 3]);
            const unsigned pk = pk2(a, b);
            Vt[(ch * 8 + 2 * e) * 136 + s] = (bf16)(pk & 0xffffu); Vt[(ch * 8 + 2 * e + 1) * 136 + s] = (bf16)(pk >> 16); } }
    __syncthreads();
    pg8::f32x4 acc[8];
#pragma unroll
    for (int c = 0; c < 8; ++c) acc[c] = (pg8::f32x4){0.f, 0.f, 0.f, 0.f};
#pragma unroll
    for (int st = 0; st < 4; ++st) if (st < nsteps) {
        const int s0 = 32 * st + 8 * fq;
        float wv[8] = {wa[st][0], wa[st][1], wa[st][2], wa[st][3], wb[st][0], wb[st][1], wb[st][2], wb[st][3]};
#pragma unroll
        for (int e = 0; e < 8; ++e) wv[e] = (s0 + e <= t) ? wv[e] : 0.f;
        u32x4 wpk; wpk.x = pk2(wv[0], wv[1]); wpk.y = pk2(wv[2], wv[3]); wpk.z = pk2(wv[4], wv[5]); wpk.w = pk2(wv[6], wv[7]);
        const bf16x8 wf = __builtin_bit_cast(bf16x8, wpk);
#pragma unroll
        for (int c = 0; c < 8; ++c) { const bf16x8 vf = *(const LAS bf16x8*)(Vt + (16 * c + fr) * 136 + 32 * st + 8 * fq);
            acc[c] = __builtin_amdgcn_mfma_f32_16x16x32_bf16(vf, wf, acc[c], 0, 0, 0); }
    }
#pragma unroll
    for (int c = 0; c < 8; ++c) {
        const float o0 = bf_lo(uu[c].x) * (acc[c][0] + bias), o1 = bf_hi(uu[c].x) * (acc[c][1] + bias), o2 = bf_lo(uu[c].y) * (acc[c][2] + bias), o3 = bf_hi(uu[c].y) * (acc[c][3] + bias);
        u32x2 o; o.x = pk2(o0, o1); o.y = pk2(o2, o3);
        *(u32x2*)(AB + tok * 1024 + g * 128 + 16 * c + 4 * fq) = o; }
    __syncthreads();
}

#ifndef PROBE_QK
#define PROBE_QK 0
#endif
constexpr int AT_KP = 272, AT_VP = 320;
constexpr int AT_KB = 0, AT_VB = 2 * 64 * AT_KP, AT_MASK = AT_VB + 2 * 64 * AT_VP, AT_KM = AT_MASK + 512, AT_TILES = AT_KM + 8192, AT_MISC = AT_TILES + 320;
constexpr int AT_MO = 0, AT_ML = 65536;
__device__ __forceinline__ int crow16(int i, int h) { return (i & 3) + 8 * (i >> 2) + 4 * h; }
__device__ __forceinline__ bf16x8 pack8(float a0, float a1, float a2, float a3, float a4, float a5, float a6, float a7) {
    u32x4 p; p.x = pk2(a0, a1); p.y = pk2(a2, a3); p.z = pk2(a4, a5); p.w = pk2(a6, a7); return __builtin_bit_cast(bf16x8, p); }
__device__ __forceinline__ s16x4 tr_read(const LAS unsigned char* p) { return __builtin_bit_cast(s16x4, __builtin_amdgcn_ds_read_tr16_b64_v4i16((LAS v4i16_t*)p)); }

__device__ __forceinline__ void attn_unit(LAS unsigned char* lds, const bf16* Q, const bf16* K, const bf16* V, const float* ksum, bf16* AB, int b, int h, int j, int tid_in) {
    int tid = tid_in; asm volatile("" : "+v"(tid));
    const int lane = tid & 63, wave = tid >> 6, wq = wave & 3, kh = wave >> 2, r = lane & 31, hh = lane >> 5;
    const int qblk = j >> 1, q0 = 128 * j;
    const size_t tokbase = (size_t)b * SEQ_;
    const size_t hbase = (size_t)(b * 4 + h) * SEQ_;
    LAS float* km = (LAS float*)(lds + AT_KM);
    LAS unsigned* MASK = (LAS unsigned*)(lds + AT_MASK);
    LAS int* TILES = (LAS int*)(lds + AT_TILES);
    LAS unsigned* MISC = (LAS unsigned*)(lds + AT_MISC);
    for (int i = tid; i < qblk * 128; i += NTHR) km[i] = (ksum[(size_t)((b * 16 + (i >> 7)) * 2) * 512 + h * 128 + (i & 127)] + ksum[(size_t)((b * 16 + (i >> 7)) * 2 + 1) * 512 + h * 128 + (i & 127)]) * (1.0f / 256.0f);
    __syncthreads();
    {
        const int qi = tid >> 2, qt = tid & 3;
        const bf16* qp = Q + (hbase + q0 + qi) * 128 + qt * 32;
        float qv[32];
#pragma unroll
        for (int c = 0; c < 4; ++c) { const u32x4 x = *(const u32x4*)(qp + 8 * c);
            qv[8 * c + 0] = bf_lo(x.x); qv[8 * c + 1] = bf_hi(x.x); qv[8 * c + 2] = bf_lo(x.y); qv[8 * c + 3] = bf_hi(x.y);
            qv[8 * c + 4] = bf_lo(x.z); qv[8 * c + 5] = bf_hi(x.z); qv[8 * c + 6] = bf_lo(x.w); qv[8 * c + 7] = bf_hi(x.w); }
        float b0 = -3e38f, b1 = -3e38f, b2 = -3e38f; int i0 = -1, i1 = -1, i2 = -1;
        for (int n = 0; n < qblk; ++n) { const LAS float* kp = km + n * 128 + qt * 32; float s = 0.f;
#pragma unroll
            for (int d = 0; d < 32; ++d) s += qv[d] * kp[d];
            s += __shfl_xor(s, 1); s += __shfl_xor(s, 2);
            if (s > b0) { b2 = b1; i2 = i1; b1 = b0; i1 = i0; b0 = s; i0 = n; } else if (s > b1) { b2 = b1; i2 = i1; b1 = s; i1 = n; } else if (s > b2) { b2 = s; i2 = n; } }
        unsigned mk = 0; if (i0 >= 0) mk |= 1u << i0; if (i1 >= 0) mk |= 1u << i1; if (i2 >= 0) mk |= 1u << i2;
        if (qt == 0) MASK[qi] = mk;
    }
    __syncthreads();
    if (wave == 0) { unsigned o = MASK[lane] | MASK[lane + 64];
#pragma unroll
        for (int s = 1; s < 64; s <<= 1) o |= __shfl_xor(o, s);
        if (lane == 0) { int nt = 0;
            for (int n = 0; n < qblk; ++n) if ((o >> n) & 1u) for (int tt = 0; tt < 4; ++tt) TILES[nt++] = n * 256 + tt * 64;
            const int own = (j & 1) ? 4 : 2;
            for (int tt = 0; tt < own; ++tt) TILES[nt++] = qblk * 256 + tt * 64;
            MISC[0] = (unsigned)nt; } }
    __syncthreads();
    const int nt = __builtin_amdgcn_readfirstlane((int)MISC[0]);
    const unsigned mymask = MASK[32 * wq + r];
    const int qpos = q0 + 32 * wq + r;
    bf16x8 qf[8];
    { const bf16* qp = Q + (hbase + qpos) * 128 + hh * 8;
#pragma unroll
      for (int st = 0; st < 8; ++st) qf[st] = *(const bf16x8*)(qp + st * 16); }
    const int skey0 = tid >> 4, sch = tid & 15;
    const unsigned loff = (unsigned)(tid * 16);
    const char* Kg = (const char*)(K + hbase * 128);
    const char* Vg = (const char*)(V + hbase * 128);
    u32x4 kr0, kr1, vr0, vr1;
#define AT_LOADK(key0) do { const char* tb_ = Kg + (size_t)(key0) * 256; kr0 = *(const u32x4*)(tb_ + loff); kr1 = *(const u32x4*)(tb_ + 8192 + loff); } while (0)
#define AT_LOADV(key0) do { const char* tb_ = Vg + (size_t)(key0) * 256; vr0 = *(const u32x4*)(tb_ + loff); vr1 = *(const u32x4*)(tb_ + 8192 + loff); } while (0)
#define AT_STOREK(buf) do { *(LAS u32x4*)(lds + AT_KB + (buf) * 64 * AT_KP + skey0 * AT_KP + sch * 16) = kr0; *(LAS u32x4*)(lds + AT_KB + (buf) * 64 * AT_KP + (skey0 + 32) * AT_KP + sch * 16) = kr1; } while (0)
#define AT_STOREV(buf) do { *(LAS u32x4*)(lds + AT_VB + (buf) * 64 * AT_VP + skey0 * AT_VP + sch * 16) = vr0; *(LAS u32x4*)(lds + AT_VB + (buf) * 64 * AT_VP + (skey0 + 32) * AT_VP + sch * 16) = vr1; } while (0)
    AT_LOADK(__builtin_amdgcn_readfirstlane(TILES[0])); AT_LOADV(__builtin_amdgcn_readfirstlane(TILES[0])); AT_STOREK(0); AT_STOREV(0);
    __syncthreads();
    f32x16 O[4];
#pragma unroll
    for (int g = 0; g < 4; ++g)
#pragma unroll
        for (int i = 0; i < 16; ++i) O[g][i] = 0.f;
    float mrun = -1e30f, lrun = 0.f;
    const float sc = 0.08838834764831845f * 1.4426950408889634f;
    const int g1 = (lane >> 4) & 1, q_ = (lane & 15) >> 2, p_ = lane & 3;
    const int koff = (32 * kh + r) * AT_KP + hh * 16;
    const int voff = (32 * kh + 4 * hh + q_) * AT_VP + (16 * g1 + 4 * p_) * 2;
    for (int it = 0; it < nt; ++it) {
        const int key0 = __builtin_amdgcn_readfirstlane(TILES[it]);
        const bool more = it + 1 < nt;
        if (more) { const int kn = __builtin_amdgcn_readfirstlane(TILES[it + 1]); AT_LOADK(kn); AT_LOADV(kn); }
        const LAS unsigned char* Kb = lds + AT_KB + (it & 1) * 64 * AT_KP + koff;
        const LAS unsigned char* Vb = lds + AT_VB + (it & 1) * 64 * AT_VP + voff;
        bf16x8 kfr[8];
#pragma unroll
        for (int st = 0; st < 8; ++st) kfr[st] = *(const LAS bf16x8*)(Kb + st * 32);
        __builtin_amdgcn_sched_barrier(0);
        f32x16 p, pe;
#pragma unroll
        for (int i = 0; i < 16; ++i) { p[i] = 0.f; pe[i] = 0.f; }
#pragma unroll
        for (int st = 0; st < 4; ++st) { p = __builtin_amdgcn_mfma_f32_32x32x16_bf16(kfr[2 * st], qf[2 * st], p, 0, 0, 0); pe = __builtin_amdgcn_mfma_f32_32x32x16_bf16(kfr[2 * st + 1], qf[2 * st + 1], pe, 0, 0, 0); }
#pragma unroll
        for (int i = 0; i < 16; ++i) p[i] += pe[i];
#if PROBE_QK
        { f32x16 pz = p; _Pragma("unroll") for (int st = 0; st < 8; ++st) pz = __builtin_amdgcn_mfma_f32_32x32x16_bf16(kfr[st], qf[st], pz, 0, 0, 0); _Pragma("unroll") for (int i = 0; i < 16; ++i) p[i] = (pz[i] > 3e38f) ? pz[i] : p[i]; }
#endif
        s16x4 vlo[4], vhi[4];
#pragma unroll
        for (int g = 0; g < 4; ++g) { vlo[g] = tr_read(Vb + g * 64); vhi[g] = tr_read(Vb + g * 64 + 8 * AT_VP); }
        __builtin_amdgcn_sched_barrier(0);
        const int n = key0 >> 8; const bool own = (n == qblk);
        float ls = 0.f;
        if (own) {
#pragma unroll
            for (int i = 0; i < 16; ++i) { const int key = key0 + 32 * kh + crow16(i, hh); p[i] = (key <= qpos) ? p[i] : -__builtin_inff(); } }
        const float bias = (own || ((mymask >> n) & 1u)) ? 0.f : -__builtin_inff();
        {
            float mxr = fmaxf(fmaxf(p[0], p[1]), fmaxf(p[2], p[3]));
#pragma unroll
            for (int i = 4; i < 16; i += 4) mxr = fmaxf(mxr, fmaxf(fmaxf(p[i], p[i + 1]), fmaxf(p[i + 2], p[i + 3])));
            float mx = mxr * sc + bias; mx = fmaxf(mx, __shfl_xor(mx, 32));
            if (__any(mx > mrun + 8.0f)) { const float mnew = fmaxf(mrun, mx), alpha = __builtin_amdgcn_exp2f(mrun - mnew); mrun = mnew; lrun *= alpha;
#pragma unroll
                for (int g = 0; g < 4; ++g)
#pragma unroll
                    for (int i = 0; i < 16; ++i) O[g][i] *= alpha; }
            const float nb = bias - mrun;
#pragma unroll
            for (int i = 0; i < 16; ++i) { p[i] = __builtin_amdgcn_exp2f(__builtin_fmaf(p[i], sc, nb)); ls += p[i]; }
        }
        lrun += ls;
        const bf16x8 pb0 = pack8(p[0], p[1], p[2], p[3], p[4], p[5], p[6], p[7]), pb1 = pack8(p[8], p[9], p[10], p[11], p[12], p[13], p[14], p[15]);
        __builtin_amdgcn_sched_barrier(0);
        s16x4 wlo[4], whi[4];
#pragma unroll
        for (int g = 0; g < 4; ++g) { wlo[g] = tr_read(Vb + 16 * AT_VP + g * 64); whi[g] = tr_read(Vb + 16 * AT_VP + g * 64 + 8 * AT_VP); }
        __builtin_amdgcn_sched_barrier(0);
#pragma unroll
        for (int g = 0; g < 4; ++g) { const bf16x8 vf = {vlo[g][0], vlo[g][1], vlo[g][2], vlo[g][3], vhi[g][0], vhi[g][1], vhi[g][2], vhi[g][3]};
            O[g] = __builtin_amdgcn_mfma_f32_32x32x16_bf16(vf, pb0, O[g], 0, 0, 0); }
#pragma unroll
        for (int g = 0; g < 4; ++g) { const bf16x8 vf = {wlo[g][0], wlo[g][1], wlo[g][2], wlo[g][3], whi[g][0], whi[g][1], whi[g][2], whi[g][3]};
            O[g] = __builtin_amdgcn_mfma_f32_32x32x16_bf16(vf, pb1, O[g], 0, 0, 0); }
        if (more) { AT_STOREK((it + 1) & 1); AT_STOREV((it + 1) & 1); }
        __syncthreads();
    }
#undef AT_LOADK
#undef AT_LOADV
#undef AT_STOREK
#undef AT_STOREV
    lrun += __shfl_xor(lrun, 32);
    LAS float* MO = (LAS float*)(lds + AT_MO);
    LAS float* ML = (LAS float*)(lds + AT_ML);
    if (kh == 1) {
#pragma unroll
        for (int g = 0; g < 4; ++g)
#pragma unroll
            for (int i = 0; i < 16; ++i) MO[(wq * 128 + 32 * g + crow16(i, hh)) * 32 + r] = O[g][i];
        if (hh == 0) { ML[wq * 64 + r] = mrun; ML[wq * 64 + 32 + r] = lrun; }
    }
    __syncthreads();
    if (kh == 0) {
        const float m2 = ML[wq * 64 + r], l2 = ML[wq * 64 + 32 + r];
        const float mt = fmaxf(mrun, m2), a1 = __builtin_amdgcn_exp2f(mrun - mt), a2 = __builtin_amdgcn_exp2f(m2 - mt);
        const float inv = 1.0f / (lrun * a1 + l2 * a2);
        bf16* op = AB + (tokbase + qpos) * 1024 + 512 + h * 128;
#pragma unroll
        for (int g = 0; g < 4; ++g)
#pragma unroll
            for (int jj = 0; jj < 4; ++jj) { float o[4];
#pragma unroll
                for (int e = 0; e < 4; ++e) { const int i = 4 * jj + e; o[e] = (O[g][i] * a1 + MO[(wq * 128 + 32 * g + crow16(i, hh)) * 32 + r] * a2) * inv; }
                u32x2 w; w.x = pk2(o[0], o[1]); w.y = pk2(o[2], o[3]);
                *(u32x2*)(op + 32 * g + 8 * jj + 4 * hh) = w; }
    }
    __syncthreads();
}
constexpr int CV_GU = 16 * 176, CV_DN = 44 * 32, CV_FFN = CV_GU + CV_DN, CV_HI = 16 * 80, CV_HO = 16 * 32, CV_CI = 16 * 96, CV_CO = 16 * 32, CV_ALL = 4 * CV_FFN + CV_HI + CV_HO + CV_CI + CV_CO;
typedef const __attribute__((address_space(4))) Args* KArgP;
__device__ __forceinline__ void convert_items(KArgP ka, unsigned char* ws, int lo, int hi, int first, int stride, int lane) {
#define IN_(i) (ka->in[i])
#define WSP(T, off) ((T*)(ws + (off)))
    for (int it = lo + first; it < hi; it += stride) {
        int r = it;
        if (r < 4 * CV_FFN) { const int f = r / CV_FFN; r -= f * CV_FFN;
            bf16* GU = WSP(bf16, WS_WFFN + f * WFFN_STRIDE); bf16* DN = WSP(bf16, WS_WFFN + f * WFFN_STRIDE + WFFN_DN);
            if (r < CV_GU) { const int kb = r / 176, nb = r % 176, n0 = 32 * nb, tile = n0 >> 8, rr = n0 & 255;
                const float* src = (rr < 128 ? IN_(3) : IN_(4)) + (size_t)f * D_ * FF_; const int c0 = tile * 128 + (rr & 127);
                transpose_item(src, FF_, D_, c0, GU, n0, IN_(2) + f * D_, kb, lane);
            } else { r -= CV_GU; const int kb = r / 32, nb = r % 32;
                transpose_item(IN_(5) + (size_t)f * FF_ * D_, D_, FF_, 32 * nb, DN, 32 * nb, nullptr, kb, lane); }
            continue; }
        r -= 4 * CV_FFN;
        if (r < CV_HI) { const int kb = r / 80, nb = r % 80; transpose_item(IN_(7), 2560, D_, 32 * nb, WSP(bf16, WS_HYBIN), 32 * nb, IN_(6), kb, lane); continue; } r -= CV_HI;
        if (r < CV_HO) { const int kb = r / 32, nb = r % 32; transpose_item(IN_(11), D_, D_, 32 * nb, WSP(bf16, WS_HYBOUT), 32 * nb, nullptr, kb, lane); continue; } r -= CV_HO;
        if (r < CV_CI) { const int kb = r / 96, nb = r % 96, n0 = 32 * nb; int c0 = n0;
            if (n0 >= 1024) { const int t = (n0 - 1024) >> 8, rr = (n0 - 1024) & 255; c0 = (rr < 128 ? 1024 : 2048) + 128 * t + (rr & 127); }
            transpose_item(IN_(12), 3072, D_, c0, WSP(bf16, WS_CONVIN), n0, IN_(6) + D_, kb, lane); continue; } r -= CV_CI;
        { const int kb = r / 32, nb = r % 32; transpose_item(IN_(14), D_, D_, 32 * nb, WSP(bf16, WS_CONVOUT), 32 * nb, nullptr, kb, lane); }
    }
#undef IN_
#undef WSP
}
#define CONVERT_ON_IDLE(nunits, lo, hi) do { const int rem_ = (nunits) % G; if (bx >= rem_) { KA_FRESH(); LANE_FRESH(); convert_items(ka, ws, (lo), (hi), (bx - rem_) * NWAVES + wave, (G - rem_) * NWAVES, lane); } } while (0)

#define RS_TABLE_FILL(S_, ssq_) do { LANE_FRESH(); PG8_LAS float* rt_ = (PG8_LAS float*)(lds + pg8::RS_TABLE_OFF); \
        for (int ix_ = tid; ix_ < pg8::RS_TABLE_UNITS * 256; ix_ += NTHR) { pg8::Unit u_; if ((S_).next(ix_ >> 8, u_)) rt_[ix_] = pg8::rstd_row((ssq_), u_.pm * 256 + (ix_ & 255), 1.0f / 1024.0f); } \
        __syncthreads(); } while (0)
#ifndef PROBE_SYNC
#define PROBE_SYNC 0
#endif
#ifndef PROBE_P0
#define PROBE_P0 0
#endif
#ifndef PROBE_G1
#define PROBE_G1 0
#endif
#ifndef PROBE_ATT
#define PROBE_ATT 0
#endif
#ifndef PROBE_MIX
#define PROBE_MIX 0
#endif
#define GSYNC() do { KA_FRESH(); XcdBarrier xb_; xb_.bar = (unsigned*)(ws + WS_BAR); xb_.x = xb_xcc_id(); xb_.st = (volatile LAS unsigned*)(lds + LDS_CTL_OFF) + 8; xcd_barrier(xb_); if (PROBE_SYNC) xcd_barrier(xb_); } while (0)
__global__ void __launch_bounds__(NTHR, 2) fwd_megakernel(Args a) {
    extern __shared__ __attribute__((aligned(16))) unsigned char lds_raw[];
    cg::grid_group grid = cg::this_grid();
    LAS unsigned char* lds = (LAS unsigned char*)lds_raw;
    const int wave = __builtin_amdgcn_readfirstlane((int)threadIdx.x >> 6);
#define LANE_FRESH() unsigned ones_ = ~0u; asm volatile("" : "+s"(ones_)); const int lane = (int)__builtin_amdgcn_mbcnt_hi(ones_, __builtin_amdgcn_mbcnt_lo(ones_, 0u)); const int tid = (wave << 6) | lane; (void)tid
    const int G = gridDim.x, bx = blockIdx.x;
    const int vcu = (G % 8 == 0) ? (bx % 8) * (G / 8) + bx / 8 : bx;
    const int gw = vcu * NWAVES + wave, NGW = G * NWAVES, NGT = G * NTHR;
#define KA_FRESH() KArgP ka = (KArgP)__builtin_amdgcn_kernarg_segment_ptr(); asm volatile("" : "+s"(ka)); unsigned char* const ws = ka->ws; (void)ws
#define IN_(i) (ka->in[i])
#define WSP(T, off) ((T*)(ws + (off)))
    {
        KA_FRESH();
        if (ws == nullptr) grid.sync();
    }
    { LANE_FRESH(); if (tid < 64) ((LAS unsigned*)(lds + LDS_CTL_OFF))[tid] = 0u; }
    __syncthreads();
    { KA_FRESH(); (void)xcd_barrier_post((unsigned*)(ws + WS_BAR), (volatile LAS unsigned*)(lds + LDS_CTL_OFF) + 8); }

#pragma unroll 1
    for (int rep = 0; rep < 1 + PROBE_P0; ++rep) {
        KA_FRESH(); LANE_FRESH(); const int gt = bx * NTHR + tid;
        float* ssq = WSP(float, WS_SSQ); float* rope = WSP(float, WS_ROPE); bf16* XB = WSP(bf16, WS_XB);
        const float* x_in = IN_(0); const int* pos = (const int*)IN_(1);
        for (int i = gt; i < M_ * 16; i += NGT) { const int tok = i >> 4, f = i & 15;
            const float ang = (float)pos[tok] * ka->inv_freq[f];
            double t = (double)ang * 0.15915494309189535; t -= __builtin_rint(t); const float fr = (float)t;
            rope[(size_t)tok * 32 + f] = __builtin_amdgcn_cosf(fr); rope[(size_t)tok * 32 + 16 + f] = __builtin_amdgcn_sinf(fr); }
        for (int m = gw; m < M_; m += NGW) { const f32x4* xr = (const f32x4*)(x_in + (size_t)m * D_) + lane; f32x4 v[4]; float s = 0.f;
#pragma unroll
            for (int j = 0; j < 4; ++j) v[j] = __builtin_nontemporal_load(xr + 64 * j);
            __builtin_amdgcn_sched_barrier(0);
#pragma unroll
            for (int j = 0; j < 4; ++j) s += (v[j][0] * v[j][0] + v[j][1] * v[j][1]) + (v[j][2] * v[j][2] + v[j][3] * v[j][3]);
            s = wave_sum(s); if (lane < 4) ((f32x4*)(ssq + (size_t)m * 16))[lane] = (f32x4){lane == 0 ? s : 0.f, 0.f, 0.f, 0.f};
            u32x2* o8 = (u32x2*)(XB + (size_t)m * D_) + lane;
#pragma unroll
            for (int j = 0; j < 4; ++j) { u32x2 w; w.x = pk2(v[j][0], v[j][1]); w.y = pk2(v[j][2], v[j][3]); o8[64 * j] = w; } }
        convert_items(ka, ws, 0, CV_FFN, gw, NGW, lane);
    }
    GSYNC();

#pragma unroll 1
    for (int f = 0; f < 4; ++f) {
        const int ri = (f == 0) ? 0 : (f == 1) ? 2 : (f == 2) ? 3 : 5, wi = (f == 0) ? 1 : (f == 1) ? 3 : (f == 2) ? 4 : 6;
#pragma unroll 1
        for (int rep = 0; rep < 1 + PROBE_G1; ++rep) {
            KA_FRESH();
            pg8::Gemm g{WSP(bf16, WS_XB), WSP(bf16, WS_WFFN + f * WFFN_STRIDE), M_, 2 * FF_, D_}; pg8::StaticOrder S; S.init(M_, 2 * FF_, G, bx);
            RS_TABLE_FILL(S, WSP(float, WS_SSQ) + (size_t)ri * M_ * 16);
            pg8::EpiSwiGLU E{WSP(bf16, WS_ACT), lds};
            pg8::gemm_phase<pg8::EpiSwiGLU, pg8::StaticOrder, true, true>(lds, g, S, E, wave);
        }
        if (f < 3) CONVERT_ON_IDLE(64 * 22, (f + 1) * CV_FFN, (f + 2) * CV_FFN);
        if (f == 0) CONVERT_ON_IDLE(64 * 22, 4 * CV_FFN, 4 * CV_FFN + CV_HI + CV_HO);
        GSYNC();
        {
            KA_FRESH();
            pg8::Gemm g{WSP(bf16, WS_ACT), WSP(bf16, WS_WFFN + f * WFFN_STRIDE + WFFN_DN), M_, D_, FF_}; pg8::StaticOrder S; S.init(M_, D_, G, bx);
            pg8::EpiResid E{WSP(bf16, WS_XB), WSP(float, WS_SSQ) + (size_t)wi * M_ * 16, 0.5f};
            pg8::gemm_phase<pg8::EpiResid, pg8::StaticOrder, true, true>(lds, g, S, E, wave);
        }
        GSYNC();
        if (f == 0) {
            {
                KA_FRESH();
                pg8::Gemm g{WSP(bf16, WS_XB), WSP(bf16, WS_HYBIN), M_, 2560, D_}; pg8::StaticOrder S; S.init(M_, 2560, G, bx);
                RS_TABLE_FILL(S, WSP(float, WS_SSQ) + (size_t)1 * M_ * 16);
                pg8::EpiHybIn E{WSP(bf16, WS_U), WSP(bf16, WS_VG), WSP(bf16, WS_Q), WSP(bf16, WS_K), WSP(bf16, WS_V), lds, WSP(float, WS_SSQV), WSP(float, WS_KSUM), WSP(float, WS_ROPE)};
                pg8::gemm_phase<pg8::EpiHybIn, pg8::StaticOrder, true, true>(lds, g, S, E, wave);
            }
            CONVERT_ON_IDLE(64 * 10, 4 * CV_FFN + CV_HI + CV_HO, CV_ALL);
            GSYNC();
#pragma unroll 1
            for (int rep = 0; rep < 1 + PROBE_MIX; ++rep) { KA_FRESH(); LANE_FRESH(); const int tq = tid;
                for (int e = bx; e < 512; e += G) gmlp_unit(lds, WSP(bf16, WS_VG), WSP(bf16, WS_U), WSP(float, WS_SSQV), IN_(8), IN_(9), IN_(10), WSP(bf16, WS_AB), e >> 2, e & 3, tq);
                for (int e0 = bx; e0 < 256; e0 += G) {
                    const int xcd = (G == 256) ? (e0 & 7) : (e0 >> 5), c = (G == 256) ? (e0 >> 3) : (e0 & 31);
#pragma unroll 1
                    for (int ar = 0; ar < 2 * (1 + PROBE_ATT); ++ar) { const int bh = 2 * xcd + (ar & 1);
                        attn_unit(lds, WSP(bf16, WS_Q), WSP(bf16, WS_K), WSP(bf16, WS_V), WSP(float, WS_KSUM), WSP(bf16, WS_AB), bh >> 2, bh & 3, (ar & 1) ? 31 - c : c, tq); } } }
            GSYNC();
            {
                KA_FRESH();
                pg8::Gemm g{WSP(bf16, WS_AB), WSP(bf16, WS_HYBOUT), M_, D_, D_}; pg8::StaticOrder S; S.init(M_, D_, G, bx);
                pg8::EpiResid E{WSP(bf16, WS_XB), WSP(float, WS_SSQ) + (size_t)2 * M_ * 16, 1.0f};
                pg8::gemm_phase<pg8::EpiResid, pg8::StaticOrder, true, true>(lds, g, S, E, wave);
            }
            GSYNC();
        }
        if (f == 2) {
            {
                KA_FRESH();
                pg8::Gemm g{WSP(bf16, WS_XB), WSP(bf16, WS_CONVIN), M_, 3072, D_}; pg8::StaticOrder S; S.init(M_, 3072, G, bx);
                RS_TABLE_FILL(S, WSP(float, WS_SSQ) + (size_t)4 * M_ * 16);
                pg8::EpiConvIn E{WSP(bf16, WS_BG), WSP(bf16, WS_Z), lds};
                pg8::gemm_phase<pg8::EpiConvIn, pg8::StaticOrder, true, true>(lds, g, S, E, wave);
            }
            GSYNC();
            {
                KA_FRESH();
                const bf16* Zb = WSP(bf16, WS_Z); const bf16* BGb = WSP(bf16, WS_BG); bf16* CMb = WSP(bf16, WS_CM); const float* conv_w = IN_(13);
                LANE_FRESH(); const int gt2 = bx * NTHR + tid;
                for (int i = gt2; i < M_ * 128; i += NGT) { const int tok = i >> 7, ch = i & 127, s = tok & (SEQ_ - 1);
                    const u32x4 z0 = *(const u32x4*)(Zb + (size_t)tok * 1024 + ch * 8);
                    u32x4 z1 = (u32x4){0u, 0u, 0u, 0u}, z2 = (u32x4){0u, 0u, 0u, 0u};
                    if (s >= 1) z1 = *(const u32x4*)(Zb + (size_t)(tok - 1) * 1024 + ch * 8);
                    if (s >= 2) z2 = *(const u32x4*)(Zb + (size_t)(tok - 2) * 1024 + ch * 8);
                    const u32x4 bg = *(const u32x4*)(BGb + (size_t)tok * 1024 + ch * 8);
                    __builtin_amdgcn_sched_barrier(0);
                    const unsigned a0[4] = {z0.x, z0.y, z0.z, z0.w}, a1[4] = {z1.x, z1.y, z1.z, z1.w}, a2[4] = {z2.x, z2.y, z2.z, z2.w}, ab[4] = {bg.x, bg.y, bg.z, bg.w};
                    unsigned o[4];
#pragma unroll
                    for (int e = 0; e < 4; ++e) { const int c = ch * 8 + 2 * e;
                        const float lo = bf_lo(ab[e]) * (conv_w[c] * bf_lo(a2[e]) + conv_w[1024 + c] * bf_lo(a1[e]) + conv_w[2048 + c] * bf_lo(a0[e]));
                        const float hi = bf_hi(ab[e]) * (conv_w[c + 1] * bf_hi(a2[e]) + conv_w[1024 + c + 1] * bf_hi(a1[e]) + conv_w[2048 + c + 1] * bf_hi(a0[e]));
                        o[e] = pk2(lo, hi); }
                    *(u32x4*)(CMb + (size_t)tok * 1024 + ch * 8) = (u32x4){o[0], o[1], o[2], o[3]}; }
            }
            GSYNC();
            {
                KA_FRESH();
                pg8::Gemm g{WSP(bf16, WS_CM), WSP(bf16, WS_CONVOUT), M_, D_, D_}; pg8::StaticOrder S; S.init(M_, D_, G, bx);
                pg8::EpiResid E{WSP(bf16, WS_XB), WSP(float, WS_SSQ) + (size_t)5 * M_ * 16, 1.0f};
                pg8::gemm_phase<pg8::EpiResid, pg8::StaticOrder, true, true>(lds, g, S, E, wave);
            }
            GSYNC();
        }
    }
    {
        KA_FRESH(); LANE_FRESH();
        float* X = ka->out; const bf16* XB = WSP(bf16, WS_XB); const float* ssq = WSP(float, WS_SSQ); const float* final_norm = IN_(15);
        for (int m = gw; m < M_; m += NGW) { const float rs = pg8::rstd_row(ssq + (size_t)6 * M_ * 16, m, 1.0f / 1024.0f);
#pragma unroll
            for (int j = 0; j < 2; ++j) { const u32x4 xb = *((const u32x4*)(XB + (size_t)m * D_) + lane + 64 * j);
                const f32x4 ga = *((const f32x4*)final_norm + 2 * (lane + 64 * j)), gb = *((const f32x4*)final_norm + 2 * (lane + 64 * j) + 1);
                f32x4 oa, ob; oa[0] = bf_lo(xb.x) * rs * ga[0]; oa[1] = bf_hi(xb.x) * rs * ga[1]; oa[2] = bf_lo(xb.y) * rs * ga[2]; oa[3] = bf_hi(xb.y) * rs * ga[3];
                ob[0] = bf_lo(xb.z) * rs * gb[0]; ob[1] = bf_hi(xb.z) * rs * gb[1]; ob[2] = bf_lo(xb.w) * rs * gb[2]; ob[3] = bf_hi(xb.w) * rs * gb[3];
                f32x4* o = (f32x4*)(X + (size_t)m * D_) + 2 * (lane + 64 * j); o[0] = oa; o[1] = ob; } }
    }
}

extern "C" void kernel_launch(void* const* d_in, const int* in_sizes, int n_in, void* d_out, int out_size, void* d_ws, size_t ws_size, hipStream_t stream) {
    static int grid = 0;
    if (grid == 0) {
        if (n_in != 16 || out_size != M_ * D_ || ws_size < WS_END) { fprintf(stderr, "kernel_launch: unexpected shapes (n_in %d out %d ws %zu)\n", n_in, out_size, ws_size); grid = -1; return; }
        int dev = 0, cus = 0, per_cu = 0;
        hipGetDevice(&dev); hipDeviceGetAttribute(&cus, hipDeviceAttributeMultiprocessorCount, dev);
        if (hipFuncSetAttribute((const void*)fwd_megakernel, hipFuncAttributeMaxDynamicSharedMemorySize, LDS_BYTES) != hipSuccess) { fprintf(stderr, "kernel_launch: hipFuncSetAttribute failed\n"); grid = -1; return; }
        if (hipOccupancyMaxActiveBlocksPerMultiprocessor(&per_cu, (const void*)fwd_megakernel, NTHR, LDS_BYTES) != hipSuccess || per_cu < 1) { fprintf(stderr, "kernel_launch: occupancy query says %d\n", per_cu); per_cu = 1; }
        (void)hipGetLastError();
        grid = cus * 1;
        if (grid > 256) grid = 256;
    }
    if (grid < 0) return;
    if (hipMemsetAsync((char*)d_ws + WS_BAR, 0, BAR_BYTES, stream) != hipSuccess) { fprintf(stderr, "kernel_launch: memset of barrier words failed\n"); return; }
    Args a{};
    for (int i = 0; i < 16; ++i) a.in[i] = (const float*)d_in[i];
    a.out = (float*)d_out; a.ws = (unsigned char*)d_ws;
    for (int i = 0; i < 16; ++i) a.inv_freq[i] = (float)pow(500000.0, -(double)i / 16.0);
    void* args[] = {&a};
    hipError_t e = hipLaunchCooperativeKernel((const void*)fwd_megakernel, dim3(grid), dim3(NTHR), args, LDS_BYTES, stream);
    if (e != hipSuccess) fprintf(stderr, "kernel_launch: cooperative launch failed: %s (grid %d)\n", hipGetErrorString(e), grid);
}
```
